# Optimizing an MI355X kernel written in HIP

```python
import math, functools
import jax, jax.numpy as jnp
from jax import lax
import numpy as np

D_MODEL = 2048
BATCH = 16
SEQ = 2048
DEPTH = 1
DEC_BATCH = 32
DEC_SEQ = 4
PAST_LEN = 16384
PAGE_SIZE = 128

MIX_WIDTH = D_MODEL
ATT_WIDTH = MIX_WIDTH // 2
LRU_WIDTH = MIX_WIDTH - ATT_WIDTH
HEAD_DIM = 128
N_ATT_HEADS = ATT_WIDTH // HEAD_DIM
LRU_BLOCKS = 8
LRU_BLOCK_W = LRU_WIDTH // LRU_BLOCKS
CONV_WIDTH = 4
LRU_C = 8.0
DILATED_PATTERNS = ((128, 1), (512, 4), (2048, 16))
MAX_WINDOW = max(w for w, _ in DILATED_PATTERNS)
N_BUCKETS = 32
MAX_DISTANCE = MAX_WINDOW
D_FF = ((8 * D_MODEL // 3 + 255) // 256) * 256
IN_WIDTH = 3 * ATT_WIDTH + 2 * LRU_WIDTH
RMS_EPS = 1e-6
NEG_INF = -1e30
ATT_SCALE = 1.0 / math.sqrt(HEAD_DIM)

kernel_name = "hybrid_dilated_attn_rglru_macaron_step"


def _rms_norm(x, g):
    xf = x.astype(jnp.float32)
    y = xf * lax.rsqrt(jnp.mean(xf * xf, axis=-1, keepdims=True) + RMS_EPS)
    return (y * g.astype(jnp.float32)).astype(x.dtype)


def _swiglu(h, w_gate, w_up, w_down):
    return (jax.nn.silu(h @ w_gate) * (h @ w_up)) @ w_down


def _rel_bucket(dist):
    max_exact = N_BUCKETS // 2
    df = jnp.maximum(dist, 1).astype(jnp.float32)
    large = max_exact + (jnp.log(df / max_exact) / math.log(MAX_DISTANCE / max_exact)
                         * (N_BUCKETS - max_exact)).astype(jnp.int32)
    return jnp.where(dist < max_exact, dist, jnp.minimum(large, N_BUCKETS - 1))


def _pattern_bias(rel_bias, window, dil):
    dist = dil * jnp.arange(window // dil + 1, dtype=jnp.int32)
    return rel_bias[_rel_bucket(dist)].T.astype(jnp.float32)


def _dilated_prompt(q, k, v, bias_j, window, dil):
    B, S, H, E = q.shape
    n = window // dil
    nb = -(-S // (dil * n))
    Sp = nb * n * dil

    def split(t):
        t = jnp.pad(t, ((0, 0), (0, Sp - S), (0, 0), (0, 0)))
        return t.reshape(B, nb, n, dil, H, E)

    def with_prev(t):
        prev = jnp.concatenate([jnp.zeros_like(t[:, :1]), t[:, :-1]], axis=1)
        return jnp.concatenate([prev, t], axis=2)

    qb = split(q)
    kc = with_prev(split(k))
    vc = with_prev(split(v))
    qq = jnp.arange(n)[:, None]
    kk = jnp.arange(2 * n)[None, :]
    j = n + qq - kk
    band = (j >= 0) & (j <= n)
    not_before_start = (jnp.arange(nb) > 0)[:, None, None] | (kk >= n)[None]
    valid = band[None] & not_before_start
    bias = bias_j[:, jnp.clip(j, 0, n)]
    s = jnp.einsum('bcqrhe,bckrhe->bcrhqk', qb, kc).astype(jnp.float32) * ATT_SCALE
    s = s + bias[None, None, None]
    s = jnp.where(valid[None, :, None, None], s, NEG_INF)
    lse = jax.nn.logsumexp(s, axis=-1)
    p = jnp.exp(s - lse[..., None]).astype(v.dtype)
    o = jnp.einsum('bcrhqk,bckrhe->bcqrhe', p, vc).reshape(B, Sp, H, E)[:, :S]
    lse = lse.transpose(0, 1, 4, 2, 3).reshape(B, Sp, H)[:, :S]
    return o, lse


def _dilated_sample(q, k_all, v_all, bias_j, window, dil):
    B, T = q.shape[:2]
    buf = k_all.shape[1] - T
    n = window // dil
    idx = buf + jnp.arange(T)[:, None] - dil * jnp.arange(n + 1)[None, :]
    valid = idx >= 0
    safe = jnp.maximum(idx, 0)
    kg = k_all[:, safe]
    vg = v_all[:, safe]
    s = jnp.einsum('bthe,btjhe->bhtj', q, kg).astype(jnp.float32) * ATT_SCALE
    s = s + bias_j[:, None, :]
    s = jnp.where(valid[None, None], s, NEG_INF)
    lse = jax.nn.logsumexp(s, axis=-1)
    p = jnp.exp(s - lse[..., None]).astype(v_all.dtype)
    o = jnp.einsum('bhtj,btjhe->bthe', p, vg)
    return o, lse.transpose(0, 2, 1)


def _mix_patterns(outs, lses):
    alpha = jax.nn.softmax(jnp.stack(lses), axis=0)
    o = jnp.einsum('pbth,pbthe->bthe', alpha, jnp.stack(outs).astype(jnp.float32))
    return o.astype(outs[0].dtype)


def _attend_prompt(q, k, v, rel_bias):
    outs, lses = [], []
    for window, dil in DILATED_PATTERNS:
        o, l = _dilated_prompt(q, k, v, _pattern_bias(rel_bias, window, dil), window, dil)
        outs.append(o)
        lses.append(l)
    return _mix_patterns(outs, lses)


def _attend_sample(q, k, v, k_past, v_past, rel_bias):
    k_all = jnp.concatenate([k_past.astype(k.dtype), k], axis=1)
    v_all = jnp.concatenate([v_past.astype(v.dtype), v], axis=1)
    outs, lses = [], []
    for window, dil in DILATED_PATTERNS:
        o, l = _dilated_sample(q, k_all, v_all, _pattern_bias(rel_bias, window, dil), window, dil)
        outs.append(o)
        lses.append(l)
    return _mix_patterns(outs, lses)


def _rg_lru_branch(xl, gate, conv_prefix, h0, conv_w, conv_b, w_a, b_a, w_x, b_x, lam):
    B, T, R = xl.shape
    xc = jnp.concatenate([conv_prefix.astype(xl.dtype), xl], axis=1)
    u = conv_b + sum(conv_w[j] * xc[:, j:j + T] for j in range(CONV_WIDTH))
    ub = u.reshape(B, T, LRU_BLOCKS, LRU_BLOCK_W)
    r = jax.nn.sigmoid(jnp.einsum('btnc,ncd->btnd', ub, w_a).reshape(B, T, R) + b_a)
    i = jax.nn.sigmoid(jnp.einsum('btnc,ncd->btnd', ub, w_x).reshape(B, T, R) + b_x)
    log_a = -LRU_C * r.astype(jnp.float32) * jax.nn.softplus(-lam.astype(jnp.float32))
    a = jnp.exp(log_a)
    bx = jnp.sqrt(-jnp.expm1(2.0 * log_a)) * (i * u).astype(jnp.float32)

    def step(h, ab):
        h = ab[0] * h + ab[1]
        return h, h

    h_last, hs = lax.scan(step, h0.astype(jnp.float32), (a.swapaxes(0, 1), bx.swapaxes(0, 1)))
    y = hs.swapaxes(0, 1).astype(xl.dtype) * jax.nn.gelu(gate)
    return y, xc[:, -(CONV_WIDTH - 1):], h_last


def _layer(x, p, attend, conv_prefix, h0):
    x = x + 0.5 * _swiglu(_rms_norm(x, p['g_ffn1']), p['w1_gate'], p['w1_up'], p['w1_down'])
    h = _rms_norm(x, p['g_mix'])
    B, T, _ = h.shape
    proj = h @ p['w_in']
    q = proj[..., :ATT_WIDTH].reshape(B, T, N_ATT_HEADS, HEAD_DIM)
    k = proj[..., ATT_WIDTH:2 * ATT_WIDTH].reshape(B, T, N_ATT_HEADS, HEAD_DIM)
    v = proj[..., 2 * ATT_WIDTH:3 * ATT_WIDTH].reshape(B, T, N_ATT_HEADS, HEAD_DIM)
    xl = proj[..., 3 * ATT_WIDTH:3 * ATT_WIDTH + LRU_WIDTH]
    gate = proj[..., 3 * ATT_WIDTH + LRU_WIDTH:]
    o_att = attend(q, k, v).reshape(B, T, ATT_WIDTH)
    y_lru, conv_new, h_new = _rg_lru_branch(xl, gate, conv_prefix, h0, p['conv_w'], p['conv_b'],
                                            p['w_a'], p['b_a'], p['w_x'], p['b_x'], p['lam'])
    groups = jnp.concatenate([_rms_norm(o_att, p['g_att_out']), _rms_norm(y_lru, p['g_lru_out'])], axis=-1)
    x = x + groups @ p['w_out']
    x = x + 0.5 * _swiglu(_rms_norm(x, p['g_ffn2']), p['w2_gate'], p['w2_up'], p['w2_down'])
    return x, k, v, conv_new, h_new


def setup_inputs(seed: int = 0) -> dict:
    key = jax.random.key(seed)
    ks = jax.random.split(key, 32)
    f32 = jnp.float32

    def nrm(k, shape, scale):
        return scale * jax.random.normal(k, shape, f32)

    def gain(k, shape):
        return 1.0 + 0.05 * jax.random.normal(k, shape, f32)

    L = DEPTH
    att_buf = min(MAX_WINDOW, PAST_LEN)
    a0 = jax.random.uniform(ks[16], (L, LRU_WIDTH), f32, minval=0.9, maxval=0.999)
    s0 = a0 ** (1.0 / LRU_C)
    lam = jnp.log(s0) - jnp.log1p(-s0)
    return {
        'x_prompt': nrm(ks[0], (BATCH, SEQ, D_MODEL), 1.0),
        'x_sample': nrm(ks[1], (DEC_BATCH, DEC_SEQ, D_MODEL), 1.0),
        'cache_k': nrm(ks[2], (L, DEC_BATCH, att_buf, N_ATT_HEADS, HEAD_DIM), 1.0),
        'cache_v': nrm(ks[3], (L, DEC_BATCH, att_buf, N_ATT_HEADS, HEAD_DIM), 1.0),
        'state_conv': nrm(ks[4], (L, DEC_BATCH, CONV_WIDTH - 1, LRU_WIDTH), 1.0),
        'state_h': nrm(ks[5], (L, DEC_BATCH, LRU_WIDTH), 0.5),
        'g_ffn1': gain(ks[6], (L, D_MODEL)),
        'w1_gate': nrm(ks[7], (L, D_MODEL, D_FF), D_MODEL ** -0.5),
        'w1_up': nrm(ks[8], (L, D_MODEL, D_FF), D_MODEL ** -0.5),
        'w1_down': nrm(ks[9], (L, D_FF, D_MODEL), D_FF ** -0.5),
        'g_mix': gain(ks[10], (L, D_MODEL)),
        'w_in': nrm(ks[11], (L, D_MODEL, IN_WIDTH), D_MODEL ** -0.5),
        'conv_w': nrm(ks[12], (L, CONV_WIDTH, LRU_WIDTH), CONV_WIDTH ** -0.5),
        'conv_b': nrm(ks[13], (L, LRU_WIDTH), 0.01),
        'w_a': nrm(ks[14], (L, LRU_BLOCKS, LRU_BLOCK_W, LRU_BLOCK_W), LRU_BLOCK_W ** -0.5),
        'b_a': nrm(ks[15], (L, LRU_WIDTH), 0.01),
        'w_x': nrm(ks[17], (L, LRU_BLOCKS, LRU_BLOCK_W, LRU_BLOCK_W), LRU_BLOCK_W ** -0.5),
        'b_x': nrm(ks[18], (L, LRU_WIDTH), 0.01),
        'lam': lam,
        'rel_bias': nrm(ks[19], (N_BUCKETS, N_ATT_HEADS), 0.3),
        'g_att_out': gain(ks[20], (L, ATT_WIDTH)),
        'g_lru_out': gain(ks[21], (L, LRU_WIDTH)),
        'w_out': nrm(ks[22], (L, MIX_WIDTH, D_MODEL), MIX_WIDTH ** -0.5),
        'g_ffn2': gain(ks[23], (L, D_MODEL)),
        'w2_gate': nrm(ks[24], (L, D_MODEL, D_FF), D_MODEL ** -0.5),
        'w2_up': nrm(ks[25], (L, D_MODEL, D_FF), D_MODEL ** -0.5),
        'w2_down': nrm(ks[26], (L, D_FF, D_MODEL), D_FF ** -0.5),
        'g_final': gain(ks[27], (D_MODEL,)),
    }


def reference(x_prompt, x_sample, cache_k, cache_v, state_conv, state_h,
              g_ffn1, w1_gate, w1_up, w1_down, g_mix, w_in, conv_w, conv_b,
              w_a, b_a, w_x, b_x, lam, rel_bias, g_att_out, g_lru_out, w_out,
              g_ffn2, w2_gate, w2_up, w2_down, g_final):
    keep = min(MAX_WINDOW, x_prompt.shape[1])
    xp, xs = x_prompt, x_sample
    kp, vp, cp, hp = [], [], [], []
    ksm, vsm, csm, hsm = [], [], [], []
    for l in range(DEPTH):
        p = {'g_ffn1': g_ffn1[l], 'w1_gate': w1_gate[l], 'w1_up': w1_up[l], 'w1_down': w1_down[l],
             'g_mix': g_mix[l], 'w_in': w_in[l], 'conv_w': conv_w[l], 'conv_b': conv_b[l],
             'w_a': w_a[l], 'b_a': b_a[l], 'w_x': w_x[l], 'b_x': b_x[l], 'lam': lam[l],
             'g_att_out': g_att_out[l], 'g_lru_out': g_lru_out[l], 'w_out': w_out[l],
             'g_ffn2': g_ffn2[l], 'w2_gate': w2_gate[l], 'w2_up': w2_up[l], 'w2_down': w2_down[l]}
        zero_conv = jnp.zeros((xp.shape[0], CONV_WIDTH - 1, LRU_WIDTH), xp.dtype)
        zero_h = jnp.zeros((xp.shape[0], LRU_WIDTH), jnp.float32)
        xp, k_l, v_l, c_l, h_l = _layer(xp, p, functools.partial(_attend_prompt, rel_bias=rel_bias),
                                        zero_conv, zero_h)
        kp.append(k_l[:, -keep:])
        vp.append(v_l[:, -keep:])
        cp.append(c_l)
        hp.append(h_l)
        attend_s = functools.partial(_attend_sample, k_past=cache_k[l], v_past=cache_v[l], rel_bias=rel_bias)
        xs, k_l, v_l, c_l, h_l = _layer(xs, p, attend_s, state_conv[l], state_h[l])
        ksm.append(k_l)
        vsm.append(v_l)
        csm.append(c_l)
        hsm.append(h_l)
    y_prompt = _rms_norm(xp, g_final)
    y_sample = _rms_norm(xs, g_final)
    return (y_prompt, y_sample, jnp.stack(kp), jnp.stack(vp), jnp.stack(cp), jnp.stack(hp),
            jnp.stack(ksm), jnp.stack(vsm), jnp.stack(csm), jnp.stack(hsm))
```

```cpp
#include <hip/hip_runtime.h>
#include <cstdio>
#include <cstdint>

#ifndef MK_N_LAUNCHES
#define MK_N_LAUNCHES 1
#endif

#define LAS __attribute__((address_space(3)))
#define GAS __attribute__((address_space(1)))

constexpr int DM = 2048, BP = 16, SP = 2048, MP = BP * SP  , BS = 32, TS = 4, MS = BS * TS  ;
constexpr int MPAD = MP + 256  , NMT = MPAD / 256  ;
constexpr int DFF = 5632, HLD = DFF + 64  , NGU = 2 * DFF, NIN = 5120, AW = 1024, NH = 8, HD = 128;
constexpr float RMS_EPS = 1e-6f;
constexpr float LOG2E = 1.4426950408889634f;
constexpr float ATT_C2 = 0.08838834764831845f * 1.4426950408889634f;
constexpr int TBN = 2432;

constexpr size_t OFF_YP = 0, OFF_YS = 67108864, OFF_KP = 67371008, OFF_VP = 100925440, OFF_CP = 134479872, OFF_HP = 134529024,
                 OFF_KS = 134545408, OFF_VS = 134676480, OFF_CS = 134807552, OFF_HS = 134905856, OUT_TOTAL = 134938624;

constexpr size_t MiB = 1u << 20;
constexpr size_t WS_CTL = 0, CTL_ZERO_BYTES = 64 * 1024;
constexpr size_t WS_RS1 = 1 * MiB, WS_SSQ2 = WS_RS1 + 256 * 1024, WS_SSQ3 = WS_RS1 + 512 * 1024, WS_SSQ4 = WS_RS1 + 768 * 1024;
constexpr size_t WS_TBL = 2 * MiB, WS_WAX = 3 * MiB, WS_SSQA = 4 * MiB, WS_SSQL = 6 * MiB;
constexpr size_t WS_WGU1 = 8 * MiB, WS_WD1 = 52 * MiB, WS_WIN = 74 * MiB, WS_WOUT = 94 * MiB, WS_WGU2 = 102 * MiB, WS_WD2 = 146 * MiB;
constexpr size_t WS_XA = 168 * MiB, WS_GRP = 297 * MiB, WS_GG = 426 * MiB, WS_H = 491 * MiB;
constexpr size_t WS_Q = WS_H, WS_KB = WS_H + 65 * MiB, WS_VB = WS_H + 130 * MiB, WS_XL = WS_H + 195 * MiB;
constexpr size_t WS_END = 852 * MiB;
static_assert((size_t)MPAD * DM * 2 <= 129 * MiB && (size_t)MPAD * HLD * 2 <= 361 * MiB && (size_t)MPAD * AW * 2 <= 65 * MiB && (size_t)MPAD * AW * 4 <= 129 * MiB, "ws map");
static_assert(WS_XL + (size_t)MPAD * AW * 4 <= WS_END && (size_t)MPAD * 8 * 4 <= 2 * MiB && (size_t)MPAD * 4 <= 256 * 1024, "ws map 2");
constexpr int CW_TMO = 0, CW_CODE = 1, CW_QUEUE = 64, CW_BAR = 4096;

constexpr int RING_BYTES = 131072, LDSCTL_OFF = RING_BYTES, MISC_OFF = LDSCTL_OFF + 320, LDS_BYTES = 147456;
constexpr int RV_OFF = LDSCTL_OFF + 512  , SCT_OFF = RV_OFF + 2048  ;
static_assert(SCT_OFF + 4 * 256 * 2 * 4 <= LDS_BYTES, "lds map");


template <int CTRL> __device__ __forceinline__ float dppf(float v) { return __builtin_bit_cast(float, __builtin_amdgcn_update_dpp(0, __builtin_bit_cast(int, v), CTRL, 0xF, 0xF, true)); }
__device__ __forceinline__ float sum_x1(float v) { return v + dppf<0xB1>(v); }
__device__ __forceinline__ float sum_x2(float v) { return v + dppf<0x4E>(v); }
__device__ __forceinline__ float sum16(float v) { v = sum_x1(v); v = sum_x2(v); v += dppf<0x141>(v); v += dppf<0x140>(v); return v; }
__device__ __forceinline__ float sum_r16(float v) { auto r = __builtin_amdgcn_permlane16_swap(__builtin_bit_cast(unsigned, v), __builtin_bit_cast(unsigned, v), false, false);
    return __builtin_bit_cast(float, (unsigned)r[0]) + __builtin_bit_cast(float, (unsigned)r[1]); }
__device__ __forceinline__ float sum_r32(float v) { auto r = __builtin_amdgcn_permlane32_swap(__builtin_bit_cast(unsigned, v), __builtin_bit_cast(unsigned, v), false, false);
    return __builtin_bit_cast(float, (unsigned)r[0]) + __builtin_bit_cast(float, (unsigned)r[1]); }

namespace pg8 {
#define PG8_LAS __attribute__((address_space(3)))
typedef unsigned short bf16_t;
typedef short bf16x8 __attribute__((ext_vector_type(8)));
typedef float f32x4 __attribute__((ext_vector_type(4)));
typedef unsigned u32x4 __attribute__((ext_vector_type(4)));
typedef unsigned u32x2 __attribute__((ext_vector_type(2)));
constexpr int BM = 256, BK = 64, HALF = 128, HTB = HALF * BK * 2, STAGE_BYTES = 8 * HTB, NXCD = 8, WGM = 8;

__host__ __device__ __forceinline__ int lds_byte(int r, int c) { const int st = (r >> 4) * 2 + (c >> 5), rr = r & 15, cc = c & 31, ob = rr * 64 + cc * 2; return st * 1024 + (ob ^ (((ob >> 9) & 1) << 5)); }
__host__ __device__ __forceinline__ void stage_rc(int b, int& R, int& C) { const int st = b / 1024, sb = b % 1024, swz = sb ^ (((sb >> 9) & 1) << 5); R = (st >> 1) * 16 + swz / 64; C = (st & 1) * 32 + (swz % 64) / 2; }
__host__ __device__ __forceinline__ int perm32(int rho) { const int n = rho >> 4, i = rho & 15; return 8 * (i >> 2) + 4 * n + (i & 3); }

struct Unit { int pm, pn; };
struct Gemm { const bf16_t* A; const bf16_t* Bt; int M, N, K, lda, ldb; };

struct StaticOrder {
    int nM, nN, nwg, G, c, R, wgm;
    __host__ __device__ __forceinline__ void init(int M, int N, int G_, int c_, bool rev = false, int wgm_ = WGM) { nM = M / BM; nN = N / BM; nwg = nM * nN; G = G_; c = c_; R = rev ? (nwg + G_ - 1) / G_ : 0; wgm = wgm_; }
    __host__ __device__ __forceinline__ bool next(int i, Unit& u) const {
        if (R > 0 && i >= R) return false;
        const long L = (long)(R > 0 ? R - 1 - i : i) * G + c; if (L >= nwg) return false;
        int wgid = (int)L; { const int q = nwg / NXCD, r = nwg % NXCD, xcd = wgid % NXCD, off = wgid / NXCD; wgid = (xcd < r ? xcd * (q + 1) : r * (q + 1) + (xcd - r) * q) + off; }
        const int nig = wgm * nN, gid = wgid / nig, fm = gid * wgm, gsz = (nM - fm) < wgm ? (nM - fm) : wgm;
        u.pm = fm + ((wgid % nig) % gsz); u.pn = (wgid % nig) / gsz; return true;
    }
    __device__ __forceinline__ void a_ready(const Unit&) const {}
    __device__ __forceinline__ void done(const Unit&) const {}
};

__device__ __forceinline__ unsigned cvt_pk_bf16(float lo, float hi) { unsigned r; asm volatile("v_cvt_pk_bf16_f32 %0, %1, %2" : "=v"(r) : "v"(lo), "v"(hi)); return r; }
__device__ __forceinline__ u32x4 pack8(const f32x4 a, const f32x4 b) { u32x4 w; w.x = cvt_pk_bf16(a[0], a[1]); w.y = cvt_pk_bf16(a[2], a[3]); w.z = cvt_pk_bf16(b[0], b[1]); w.w = cvt_pk_bf16(b[2], b[3]); return w; }
__device__ __forceinline__ float fast_rcp(float x) { return __builtin_amdgcn_rcpf(x); }
__device__ __forceinline__ float fast_exp2(float x) { return __builtin_amdgcn_exp2f(x); }
__device__ __forceinline__ float silu_f(float x) { return x * fast_rcp(1.0f + fast_exp2(-x * 1.4426950408889634f)); }
__device__ __forceinline__ float sigmoid_f(float x) { return fast_rcp(1.0f + fast_exp2(-x * 1.4426950408889634f)); }
__device__ __forceinline__ float gelu_tanh_f(float x) { const float z = 0.7978845608028654f * (x + 0.044715f * x * x * x); return x * fast_rcp(1.0f + fast_exp2(-2.0f * 1.4426950408889634f * z)); }


template <bool FROM_SSQ> struct EpiSwiGLU {
    static constexpr bool PERM = true, AFTER_DRAIN = false; static constexpr int ROWVEC = 1;
    bf16_t* Hout; const float* rowvec;
    __device__ __forceinline__ void operator()(const f32x4 (&acc)[2][2][4][2], const Unit& u, int ui, const PG8_LAS float* rv, int wr, int wc, int fr_in, int fq_in) const {
        int fr = fr_in, fq = fq_in; asm volatile("" : "+v"(fr), "+v"(fq));
        const int rl0 = wr * 64 + fr, row0 = u.pm * BM + rl0, colh = u.pn * 128 + wc * 32 + 8 * fq;
#pragma unroll
        for (int ai = 0; ai < 2; ++ai) {
#pragma unroll
            for (int m = 0; m < 4; ++m) {
                const int row = row0 + ai * HALF + m * 16;
                const float rvv = rv[rl0 + ai * HALF + m * 16];
                const float s = FROM_SSQ ? 1.0f / sqrtf(rvv * (1.0f / DM) + RMS_EPS) : rvv;
                f32x4 h0, h1;
#pragma unroll
                for (int j = 0; j < 4; ++j) { h0[j] = silu_f(acc[ai][0][m][0][j] * s) * (acc[ai][1][m][0][j] * s); h1[j] = silu_f(acc[ai][0][m][1][j] * s) * (acc[ai][1][m][1][j] * s); }
                *(u32x4*)(Hout + (size_t)row * HLD + colh) = pack8(h0, h1);
            }
        }
    }
};

template <int SC, bool BASE_F32>
struct EpiRes {
    static constexpr bool PERM = true, AFTER_DRAIN = false; static constexpr int ROWVEC = 0;
    const float* baseP; bf16_t* xa; float* ssq; const PG8_LAS float* sct; float coef; const float* rowvec;
    __device__ __forceinline__ void midk(f32x4 (&acc)[2][2][4][2], int ui, int wr, int fr_in) const {
        int fr = fr_in; asm volatile("" : "+v"(fr));
#pragma unroll
        for (int ai = 0; ai < 2; ++ai)
#pragma unroll
            for (int m = 0; m < 4; ++m) { const float r = sct[(ui * 256 + wr * 64 + fr + ai * HALF + m * 16) * 2];
#pragma unroll
                for (int bj = 0; bj < 2; ++bj)
#pragma unroll
                    for (int n = 0; n < 2; ++n) acc[ai][bj][m][n] = acc[ai][bj][m][n] * r; }
    }
    __device__ __forceinline__ void operator()(const f32x4 (&acc)[2][2][4][2], const Unit& u, int ui, const PG8_LAS float* rv, int wr, int wc, int fr_in, int fq_in) const {
        int fr = fr_in, fq = fq_in; asm volatile("" : "+v"(fr), "+v"(fq));
        const int rl0 = wr * 64 + fr, row0 = u.pm * BM + rl0, col0 = u.pn * BM + wc * 32 + 8 * fq;
#pragma unroll
        for (int ai = 0; ai < 2; ++ai) {
            f32x4 bb[4][2][2];
#pragma unroll
            for (int m = 0; m < 4; ++m)
#pragma unroll
                for (int bj = 0; bj < 2; ++bj) { const size_t off = (size_t)(row0 + ai * HALF + m * 16) * DM + col0 + bj * HALF;
                    if (BASE_F32) { bb[m][bj][0] = *(const f32x4*)(baseP + off); bb[m][bj][1] = *(const f32x4*)(baseP + off + 4); }
                    else { const u32x4 w = *(const u32x4*)(xa + off);
                        bb[m][bj][0] = (f32x4){__builtin_bit_cast(float, w.x << 16), __builtin_bit_cast(float, w.x & 0xffff0000u), __builtin_bit_cast(float, w.y << 16), __builtin_bit_cast(float, w.y & 0xffff0000u)};
                        bb[m][bj][1] = (f32x4){__builtin_bit_cast(float, w.z << 16), __builtin_bit_cast(float, w.z & 0xffff0000u), __builtin_bit_cast(float, w.w << 16), __builtin_bit_cast(float, w.w & 0xffff0000u)}; } }
            asm volatile("" ::: "memory");
#pragma unroll
            for (int m = 0; m < 4; ++m) {
                const int row = row0 + ai * HALF + m * 16;
                float sc = coef;
                if (SC) sc = coef * sct[(ui * 256 + rl0 + ai * HALF + m * 16) * 2 + (SC - 1)];
                float ss = 0.f;
#pragma unroll
                for (int bj = 0; bj < 2; ++bj) {
                    const int c = col0 + bj * HALF;
                    const f32x4 x0 = bb[m][bj][0] + acc[ai][bj][m][0] * sc, x1 = bb[m][bj][1] + acc[ai][bj][m][1] * sc;
                    *(u32x4*)(xa + (size_t)row * DM + c) = pack8(x0, x1);
                    ss += ((x0[0] * x0[0] + x0[1] * x0[1]) + (x0[2] * x0[2] + x0[3] * x0[3])) + ((x1[0] * x1[0] + x1[1] * x1[1]) + (x1[2] * x1[2] + x1[3] * x1[3]));
                }
                ss = sum_r16(ss); ss = sum_r32(ss);
                if (fq == 0) __hip_atomic_fetch_add(ssq + row, ss, __ATOMIC_RELAXED, __HIP_MEMORY_SCOPE_AGENT);
            }
            asm volatile("" ::: "memory");
        }
    }
};

struct EpiIn {
    static constexpr bool PERM = true, AFTER_DRAIN = false; static constexpr int ROWVEC = 1;
    const float* rowvec; bf16_t* Q; bf16_t* Kb; bf16_t* Vb; bf16_t* XL; bf16_t* GG; float* out;
    __device__ __forceinline__ void operator()(const f32x4 (&acc)[2][2][4][2], const Unit& u, int ui, const PG8_LAS float* rv, int wr, int wc, int fr_in, int fq_in) const {
        int fr = fr_in, fq = fq_in; asm volatile("" : "+v"(fr), "+v"(fq));
        const int rl0 = wr * 64 + fr, row0 = u.pm * BM + rl0, seg = u.pn >> 2, cs0 = (u.pn & 3) * BM + wc * 32 + 8 * fq;
#pragma unroll
        for (int ai = 0; ai < 2; ++ai) {
#pragma unroll
            for (int m = 0; m < 4; ++m) {
                const int row = row0 + ai * HALF + m * 16;
                const float s = 1.0f / sqrtf(rv[rl0 + ai * HALF + m * 16] * (1.0f / DM) + RMS_EPS);
#pragma unroll
                for (int bj = 0; bj < 2; ++bj) {
                    const int cs = cs0 + bj * HALF;
                    f32x4 v0 = acc[ai][bj][m][0] * s, v1 = acc[ai][bj][m][1] * s;
                    if (seg == 0) { *(u32x4*)(Q + (size_t)row * AW + cs) = pack8(v0 * ATT_C2, v1 * ATT_C2); }
                    else if (seg == 1 || seg == 2) {
                        bf16_t* bb = seg == 1 ? Kb : Vb; *(u32x4*)(bb + (size_t)row * AW + cs) = pack8(v0, v1);
                        float* o = out + (seg == 1 ? OFF_KP : OFF_VP) + (size_t)row * AW + cs;
                        *(f32x4*)o = v0; *(f32x4*)(o + 4) = v1; }
                    else if (seg == 3) { *(u32x4*)(XL + (size_t)row * AW + cs) = pack8(v0, v1); }
                    else {
#pragma unroll
                        for (int j = 0; j < 4; ++j) { v0[j] = gelu_tanh_f(v0[j]); v1[j] = gelu_tanh_f(v1[j]); }
                        *(u32x4*)(GG + (size_t)row * AW + cs) = pack8(v0, v1); }
                }
            }
        }
    }
};

template <class Epi, class Sched, bool ALIGN_EPI = false, bool SP2 = false, bool MIDK = false>
__device__ __forceinline__ void gemm_phase(PG8_LAS unsigned char* lds, const Gemm g, const Sched& S, const Epi& E, const int tid, const int wid) {
    const int lane = tid & 63, wr = wid >> 2, wc = wid & 3, fr = lane & 15, fq = lane >> 4;
    const int K = g.K, nt = K / BK;
    unsigned voffA[2], voffB[2];
#pragma unroll
    for (int i = 0; i < 2; ++i) { int R, C; stage_rc(tid * 16 + i * 8192, R, C); const int Rb = Epi::PERM ? ((R & ~31) + perm32(R & 31)) : R;
        voffA[i] = (unsigned)(R * g.lda + C) * 2u; voffB[i] = (unsigned)(Rb * g.ldb + C) * 2u; }
    const size_t kstep = (size_t)(BK * 2);
    const size_t hstepA = (size_t)HALF * g.lda * 2, hstepB = (size_t)HALF * g.ldb * 2;
    const size_t tstepA = 2 * hstepA, tstepB = 2 * hstepB;
    const unsigned ldsw = (unsigned)wid * 1024u;
    const int aoff = lds_byte(wr * 64 + fr, fq * 8), boff = lds_byte(wc * 32 + fr, fq * 8);
#define PG8_SA(b, h) (((b) * 2 + (h)) * HTB)
#define PG8_SB(b, h) ((4 + (b) * 2 + (h)) * HTB)
#define PG8_STAGE(bufoff, gbase, voff) do { _Pragma("unroll") for (int _i = 0; _i < 2; ++_i) \
        __builtin_amdgcn_global_load_lds((const unsigned*)((const char*)(gbase) + (voff)[_i]), (PG8_LAS unsigned*)(lds + (bufoff) + ldsw + _i * 8192), 16, 0, 0); } while (0)
#define PG8_LDA(dst, b, h) do { _Pragma("unroll") for (int m = 0; m < 4; ++m) _Pragma("unroll") for (int k = 0; k < 2; ++k) dst[m][k] = *(const PG8_LAS bf16x8*)(lds + PG8_SA(b, h) + aoff + m * 2048 + k * 1024); } while (0)
#define PG8_LDB(dst, b, h) do { _Pragma("unroll") for (int n = 0; n < 2; ++n) _Pragma("unroll") for (int k = 0; k < 2; ++k) dst[n][k] = *(const PG8_LAS bf16x8*)(lds + PG8_SB(b, h) + boff + n * 2048 + k * 1024); } while (0)
#define PG8_MMA(ai, bj, At, Bt) do { __builtin_amdgcn_s_setprio(1); _Pragma("unroll") for (int m = 0; m < 4; ++m) _Pragma("unroll") for (int n = 0; n < 2; ++n) _Pragma("unroll") for (int k = 0; k < 2; ++k) \
        acc[ai][bj][m][n] = __builtin_amdgcn_mfma_f32_16x16x32_bf16(Bt[n][k], At[m][k], acc[ai][bj][m][n], 0, 0, 0); __builtin_amdgcn_s_setprio(0); } while (0)
#define PG8_WAIT_V(n) asm volatile("s_waitcnt vmcnt(" #n ")" ::: "memory")
#define PG8_WAIT_L(n) asm volatile("s_waitcnt lgkmcnt(" #n ")" ::: "memory")
#define PG8_BAR __builtin_amdgcn_s_barrier()
#define PG8_SCHED __builtin_amdgcn_sched_barrier(0)
    Unit cur, nxt; int ui = 0;
    if (!S.next(0, cur)) return;
    f32x4 acc[2][2][4][2];
#pragma unroll
    for (int a = 0; a < 2; ++a)
#pragma unroll
        for (int b = 0; b < 2; ++b)
#pragma unroll
            for (int m = 0; m < 4; ++m)
#pragma unroll
                for (int n = 0; n < 2; ++n) acc[a][b][m][n] = (f32x4){0.f, 0.f, 0.f, 0.f};
    bf16x8 At[4][2], B0[2][2], B1[2][2];
    const char* cA = (const char*)g.A + (size_t)cur.pm * tstepA; const char* cB = (const char*)g.Bt + (size_t)cur.pn * tstepB;
    S.a_ready(cur);
    if constexpr (SP2) {
        PG8_STAGE(PG8_SB(0, 0), cB, voffB); PG8_STAGE(PG8_SB(0, 1), cB + hstepB, voffB); PG8_STAGE(PG8_SA(0, 0), cA, voffA); PG8_STAGE(PG8_SA(0, 1), cA + hstepA, voffA);
        if (wr == 1) PG8_BAR;
        PG8_WAIT_V(2); PG8_BAR;
        PG8_STAGE(PG8_SB(1, 0), cB + kstep, voffB); PG8_STAGE(PG8_SA(1, 0), cA + kstep, voffA); PG8_STAGE(PG8_SB(1, 1), cB + hstepB + kstep, voffB);
        PG8_WAIT_V(6); PG8_BAR;
    } else {
        PG8_STAGE(PG8_SB(0, 0), cB, voffB); PG8_STAGE(PG8_SA(0, 0), cA, voffA); PG8_STAGE(PG8_SB(0, 1), cB + hstepB, voffB); PG8_STAGE(PG8_SA(0, 1), cA + hstepA, voffA);
        if (wr == 1) PG8_BAR;
        PG8_WAIT_V(4); PG8_BAR;
        PG8_STAGE(PG8_SB(1, 0), cB + kstep, voffB); PG8_STAGE(PG8_SA(1, 0), cA + kstep, voffA); PG8_STAGE(PG8_SB(1, 1), cB + hstepB + kstep, voffB);
        PG8_WAIT_V(6); PG8_BAR;
    }
    for (;;) {
        const bool has_next = S.next(ui + 1, nxt);
        const char* nA = has_next ? (const char*)g.A + (size_t)nxt.pm * tstepA : cA; const char* nB = has_next ? (const char*)g.Bt + (size_t)nxt.pn * tstepB : cB;
        if constexpr (Epi::ROWVEC != 0) { if (wid < 4) {
            int ln = fr | (fq << 4); asm volatile("" : "+v"(ln));
            __builtin_amdgcn_global_load_lds((const unsigned*)(E.rowvec + (size_t)cur.pm * BM + wid * 64 + ln), (PG8_LAS unsigned*)(lds + RV_OFF + (ui & 1) * 1024 + wid * 256), 4, 0, 0); } }
        for (int hseg = 0; hseg < (MIDK ? 2 : 1); ++hseg) {
        const int tbeg = MIDK ? hseg * (nt / 2) : 0, tend = MIDK ? tbeg + nt / 2 : nt;
        for (int t = tbeg; t < tend; t += 2) {
            const bool last = (t == nt - 2);
            const char* a1 = cA + (size_t)(t + 1) * kstep;
            const char* a2 = last ? nA : cA + (size_t)(t + 2) * kstep; const char* b2 = last ? nB : cB + (size_t)(t + 2) * kstep;
            const char* a3 = a2 + kstep; const char* b3 = b2 + kstep;
            if (last && has_next) S.a_ready(nxt);
            if constexpr (SP2) {
            PG8_LDB(B0, 0, 0); PG8_LDB(B1, 0, 1); PG8_SCHED; PG8_LDA(At, 0, 0); PG8_STAGE(PG8_SA(1, 1), a1 + hstepA, voffA);
            PG8_WAIT_V(8); PG8_WAIT_L(0); PG8_BAR; PG8_MMA(0, 0, At, B0); PG8_MMA(0, 1, At, B1); PG8_BAR; PG8_SCHED;
            PG8_LDA(At, 0, 1); PG8_STAGE(PG8_SB(0, 0), b2, voffB); PG8_STAGE(PG8_SB(0, 1), b2 + hstepB, voffB); PG8_STAGE(PG8_SA(0, 0), a2, voffA);
            PG8_WAIT_V(8); PG8_WAIT_L(0); PG8_BAR; PG8_MMA(1, 0, At, B0); PG8_MMA(1, 1, At, B1); PG8_BAR; PG8_SCHED;
            PG8_LDB(B0, 1, 0); PG8_LDB(B1, 1, 1); PG8_SCHED; PG8_LDA(At, 1, 0); PG8_STAGE(PG8_SA(0, 1), a2 + hstepA, voffA);
            PG8_WAIT_V(8); PG8_WAIT_L(0); PG8_BAR; PG8_MMA(0, 0, At, B0); PG8_MMA(0, 1, At, B1); PG8_BAR; PG8_SCHED;
            PG8_LDA(At, 1, 1); PG8_STAGE(PG8_SB(1, 0), b3, voffB); PG8_STAGE(PG8_SB(1, 1), b3 + hstepB, voffB); PG8_STAGE(PG8_SA(1, 0), a3, voffA);
            PG8_WAIT_V(8); PG8_WAIT_L(0); PG8_BAR; PG8_MMA(1, 0, At, B0); PG8_MMA(1, 1, At, B1); PG8_BAR; PG8_SCHED;
            } else {
            PG8_LDB(B0, 0, 0); PG8_SCHED; PG8_LDA(At, 0, 0); PG8_STAGE(PG8_SA(1, 1), a1 + hstepA, voffA);
            PG8_WAIT_L(8); PG8_BAR; PG8_WAIT_L(0); PG8_MMA(0, 0, At, B0); PG8_BAR; PG8_SCHED;
            PG8_LDB(B1, 0, 1); PG8_STAGE(PG8_SB(0, 0), b2, voffB);
            PG8_BAR; PG8_WAIT_L(0); PG8_MMA(0, 1, At, B1); PG8_BAR;
            PG8_LDA(At, 0, 1); PG8_STAGE(PG8_SA(0, 0), a2, voffA);
            PG8_BAR; PG8_WAIT_L(0); PG8_MMA(1, 0, At, B0); PG8_BAR; PG8_SCHED;
            PG8_STAGE(PG8_SB(0, 1), b2 + hstepB, voffB);
            PG8_WAIT_V(6); PG8_BAR; PG8_MMA(1, 1, At, B1); PG8_BAR;
            PG8_LDB(B0, 1, 0); PG8_SCHED; PG8_LDA(At, 1, 0); PG8_STAGE(PG8_SA(0, 1), a2 + hstepA, voffA);
            PG8_WAIT_L(8); PG8_BAR; PG8_WAIT_L(0); PG8_MMA(0, 0, At, B0); PG8_BAR; PG8_SCHED;
            PG8_LDB(B1, 1, 1); PG8_STAGE(PG8_SB(1, 0), b3, voffB);
            PG8_BAR; PG8_WAIT_L(0); PG8_MMA(0, 1, At, B1); PG8_BAR;
            PG8_LDA(At, 1, 1); PG8_STAGE(PG8_SA(1, 0), a3, voffA);
            PG8_BAR; PG8_WAIT_L(0); PG8_MMA(1, 0, At, B0); PG8_BAR; PG8_SCHED;
            PG8_STAGE(PG8_SB(1, 1), b3 + hstepB, voffB);
            PG8_WAIT_V(6); PG8_BAR; PG8_MMA(1, 1, At, B1); PG8_BAR;
            }
        }
        if constexpr (MIDK) { if (hseg == 0) E.midk(acc, ui, wr, fr); }
        }
        if constexpr (ALIGN_EPI) { if (wr == 0) PG8_BAR; }
        E(acc, cur, ui, (const PG8_LAS float*)(lds + RV_OFF + (ui & 1) * 1024), wr, wc, fr, fq); S.done(cur);
        if (!has_next) break;
#pragma unroll
        for (int a = 0; a < 2; ++a)
#pragma unroll
            for (int b = 0; b < 2; ++b)
#pragma unroll
                for (int m = 0; m < 4; ++m)
#pragma unroll
                    for (int n = 0; n < 2; ++n) acc[a][b][m][n] = (f32x4){0.f, 0.f, 0.f, 0.f};
        cur = nxt; cA = nA; cB = nB; ++ui;
        if constexpr (ALIGN_EPI) { if (wr == 1) PG8_BAR; }
    }
    PG8_WAIT_V(0);
    if constexpr (!ALIGN_EPI) { if (wr == 0) PG8_BAR; }
    PG8_BAR;
#undef PG8_SA
#undef PG8_SB
#undef PG8_STAGE
#undef PG8_LDA
#undef PG8_LDB
#undef PG8_MMA
#undef PG8_WAIT_V
#undef PG8_WAIT_L
#undef PG8_BAR
#undef PG8_SCHED
}
}

typedef unsigned short bf16;
typedef unsigned v4u __attribute__((ext_vector_type(4)));
typedef unsigned v2u __attribute__((ext_vector_type(2)));
typedef float f32x4 __attribute__((ext_vector_type(4)));
typedef float f32x16 __attribute__((ext_vector_type(16)));
typedef short bf16x8 __attribute__((ext_vector_type(8)));
typedef short s16x4 __attribute__((ext_vector_type(4)));
typedef GAS unsigned gu32;
#define RLX_AGENT __ATOMIC_RELAXED, __HIP_MEMORY_SCOPE_AGENT
#define LDS_WAIT() asm volatile("s_waitcnt lgkmcnt(0)" ::: "memory")
#define VM_WAIT() asm volatile("s_waitcnt vmcnt(0)" ::: "memory")
__device__ __forceinline__ unsigned f2bf(float f) { unsigned u = __builtin_bit_cast(unsigned, f); return (u + 0x7fffu + ((u >> 16) & 1u)) >> 16; }
__device__ __forceinline__ unsigned pk2(float lo, float hi) { return f2bf(lo) | (f2bf(hi) << 16); }
__device__ __forceinline__ float bf2f(unsigned short b) { return __builtin_bit_cast(float, ((unsigned)b) << 16); }

#define XB_TMO      128
#define XB_XCNT(j)  (256  + 64 * (j))
#define XB_XSUB(j)  (1280 + 64 * (j))
#define XB_XGEN(j)  (2304 + 64 * (j))
#define XB_TOP      3328
#define XB_TOPGEN   3392
#define XCD_BAR_WORDS 3456
#define XB_SPIN_CAP (1u << 18)
__device__ __forceinline__ unsigned xb_ld(unsigned* p)              { return __hip_atomic_load(p, __ATOMIC_RELAXED, __HIP_MEMORY_SCOPE_AGENT); }
__device__ __forceinline__ unsigned xb_add(unsigned* p, unsigned v) { return __hip_atomic_fetch_add(p, v, __ATOMIC_RELAXED, __HIP_MEMORY_SCOPE_AGENT); }
__device__ __forceinline__ unsigned xb_xcc_id() { return (unsigned)__builtin_amdgcn_s_getreg((3 << 11) | 20) & 0xFu; }
#define XB_SPIN(cond, bar) do { unsigned _sp = 0; while (cond) { __builtin_amdgcn_s_sleep(1); \
    if ((++_sp & 255u) == 0u) { if (xb_ld(&(bar)[XB_TMO])) break; if (_sp > XB_SPIN_CAP) { atomicAdd(&(bar)[XB_TMO], 1u); break; } } } } while (0)
struct XcdBarrier { unsigned* bar; unsigned x; volatile LAS unsigned* st; };
__device__ __forceinline__ XcdBarrier xcd_barrier_post(unsigned* bar, volatile LAS unsigned* st, const bool leader  ) {
    XcdBarrier b; b.bar = bar; b.x = xb_xcc_id(); b.st = st;
    if (leader) (void)xb_add(&bar[XB_XCNT(b.x)], 1u);
    return b;
}
__device__ __forceinline__ void xcd_barrier_complete(unsigned* bar, unsigned x, unsigned& nloc, unsigned& nx) {
    const unsigned G = gridDim.x * gridDim.y * gridDim.z;
    unsigned sum, cnt, mine, sp = 0u;
    for (;;) {
        sum = 0u; cnt = 0u; mine = 0u;
#pragma unroll
        for (unsigned j = 0; j < 16; ++j) { const unsigned c = xb_ld(&bar[XB_XCNT(j)]); sum += c; cnt += (c > 0u) ? 1u : 0u; mine = (j == x) ? c : mine; }
        if (sum == G) break;
        __builtin_amdgcn_s_sleep(1);
        if ((++sp & 255u) == 0u) { if (xb_ld(&bar[XB_TMO])) break; if (sp > XB_SPIN_CAP) { atomicAdd(&bar[XB_TMO], 1u); break; } }
    }
    nloc = mine > 0u ? mine : 1u; nx = cnt > 0u ? cnt : 1u;
}
__device__ __forceinline__ void xcd_barrier(const XcdBarrier& b, const bool leader  ) {
    asm volatile("s_waitcnt vmcnt(0)" ::: "memory");
    __syncthreads();
    if (leader) {
        unsigned* bar = b.bar;
        __builtin_amdgcn_s_waitcnt(0);
        unsigned nloc = b.st[0], nx = b.st[1];
        if (nloc == 0u) { xcd_barrier_complete(bar, b.x, nloc, nx); b.st[0] = nloc; b.st[1] = nx; }
        const unsigned old = xb_add(&bar[XB_XSUB(b.x)], 1u);
        const unsigned gen = old / nloc;
        if (old + 1u == (gen + 1u) * nloc) {
            __builtin_amdgcn_fence(__ATOMIC_RELEASE, "agent");
            asm volatile("s_waitcnt vmcnt(0)" ::: "memory");
            const unsigned og = xb_add(&bar[XB_TOP], 1u);
            const unsigned tg = og / nx;
            if (og + 1u == (tg + 1u) * nx) xb_add(&bar[XB_TOPGEN], 1u);
            else XB_SPIN(xb_ld(&bar[XB_TOPGEN]) == tg, bar);
            __builtin_amdgcn_fence(__ATOMIC_ACQUIRE, "agent");
            xb_add(&bar[XB_XGEN(b.x)], 1u);
            asm volatile("s_waitcnt vmcnt(0)" ::: "memory");
        } else {
            XB_SPIN(xb_ld(&bar[XB_XGEN(b.x)]) == gen, bar);
            __builtin_amdgcn_fence(__ATOMIC_ACQUIRE, "agent");
            asm volatile("s_waitcnt vmcnt(0)" ::: "memory");
        }
    }
    __syncthreads();
}

constexpr int NWAVES = 8;
struct Args { const float* in[28]; float* out; unsigned char* ws; int ph_lo, ph_hi; };
struct Frame {
    LAS unsigned char* lds;
    volatile LAS unsigned* MISC;
    gu32* ctl;
    int tid, lane, wave, G;
    float* out; unsigned char* ws;
};
__device__ __forceinline__ float wave_sum(float v) {
    v = sum16(v); v = sum_r16(v); v = sum_r32(v);
    return v;
}

__device__ __forceinline__ void p0_transpose_item(const float* W, const float* gk, int K, int N, bf16* WT, int mode, LAS float* scr, int item, int lane) {
    const int nblk = N / 32, kb = item / nblk, nb = item % nblk, k0 = 64 * kb, n0 = 32 * nb;
    { f32x4 v[8]; float g[8];
#pragma unroll
      for (int i = 0; i < 8; ++i) { const int kk = 8 * i + (lane >> 3); v[i] = *(const GAS f32x4*)(W + (size_t)(k0 + kk) * N + n0 + 4 * (lane & 7)); g[i] = gk ? gk[k0 + kk] : 1.0f; }
#pragma unroll
      for (int i = 0; i < 8; ++i) { const int kk = 8 * i + (lane >> 3); LAS float* d = scr + kk * 33 + 4 * (lane & 7); d[0] = v[i].x * g[i]; d[1] = v[i].y * g[i]; d[2] = v[i].z * g[i]; d[3] = v[i].w * g[i]; } }
    LDS_WAIT(); asm volatile("" ::: "memory");
    const int c = lane & 7;
#pragma unroll
    for (int j = 0; j < 4; ++j) { const int n = n0 + (lane >> 3) + 8 * j; const LAS float* s = scr + (8 * c) * 33 + (n - n0);
        v4u o; o.x = pk2(s[0 * 33], s[1 * 33]); o.y = pk2(s[2 * 33], s[3 * 33]); o.z = pk2(s[4 * 33], s[5 * 33]); o.w = pk2(s[6 * 33], s[7 * 33]);
        const int drow = mode == 0 ? n : (256 * (n >> 7) + (n & 127) + (mode == 2 ? 128 : 0));
        *(GAS v4u*)(WT + (size_t)drow * K + k0 + 8 * c) = o; }
    LDS_WAIT(); asm volatile("" ::: "memory");
}
__constant__ int BUCKET_TH[15] = {22, 30, 40, 54, 73, 99, 134, 182, 246, 332, 450, 609, 825, 1117, 1513};
__device__ __forceinline__ float t2_value(const float* rel_bias, int h, int d) {
    const int m = (d <= 128 ? 1 : 0) + (((d & 3) == 0 && d <= 512) ? 1 : 0) + (((d & 15) == 0 && d <= 2048) ? 1 : 0);
    if (m == 0) return -__builtin_inff();
    int bucket = d;
    if (d >= 16) { bucket = 16; for (int k = 0; k < 15; ++k) bucket += (d >= BUCKET_TH[k]) ? 1 : 0; if (bucket > 31) bucket = 31; }
    const float lm = m == 1 ? 0.f : (m == 2 ? 0.6931471805599453f : 1.0986122886681098f);
    return (rel_bias[bucket * NH + h] + lm) * LOG2E;
}
__device__ __forceinline__ void p0_prologue(Frame& F, const Args& AR) {
    LAS float* scr = (LAS float*)(F.lds + F.wave * 16384);
    const int gw = blockIdx.x * NWAVES + F.wave, NGW = F.G * NWAVES;
    unsigned char* ws = F.ws;
    constexpr int I_GU = (DM / 64) * (DFF / 32), I_DN = (DFF / 64) * (DM / 32), I_IN = (DM / 64) * (NIN / 32), I_OUT = (DM / 64) * (DM / 32);
    constexpr int NITEMS = 4 * I_GU + 2 * I_DN + I_IN + I_OUT;
    for (int it = gw; it < NITEMS; it += NGW) {
        int r = it;
        if (r < I_GU) { p0_transpose_item(AR.in[7], AR.in[6], DM, DFF, (bf16*)(ws + WS_WGU1), 1, scr, r, F.lane); continue; } r -= I_GU;
        if (r < I_GU) { p0_transpose_item(AR.in[8], AR.in[6], DM, DFF, (bf16*)(ws + WS_WGU1), 2, scr, r, F.lane); continue; } r -= I_GU;
        if (r < I_DN) { p0_transpose_item(AR.in[9], nullptr, DFF, DM, (bf16*)(ws + WS_WD1), 0, scr, r, F.lane); continue; } r -= I_DN;
        if (r < I_GU) { p0_transpose_item(AR.in[24], AR.in[23], DM, DFF, (bf16*)(ws + WS_WGU2), 1, scr, r, F.lane); continue; } r -= I_GU;
        if (r < I_GU) { p0_transpose_item(AR.in[25], AR.in[23], DM, DFF, (bf16*)(ws + WS_WGU2), 2, scr, r, F.lane); continue; } r -= I_GU;
        if (r < I_DN) { p0_transpose_item(AR.in[26], nullptr, DFF, DM, (bf16*)(ws + WS_WD2), 0, scr, r, F.lane); continue; } r -= I_DN;
        if (r < I_IN) { p0_transpose_item(AR.in[11], AR.in[10], DM, NIN, (bf16*)(ws + WS_WIN), 0, scr, r, F.lane); continue; } r -= I_IN;
        { const int kb = r / (DM / 32); const float* gk = (64 * kb < AW) ? AR.in[20] : (AR.in[21] - AW);
          p0_transpose_item(AR.in[22], gk, DM, DM, (bf16*)(ws + WS_WOUT), 0, scr, r, F.lane); }
    }
    bf16* XA = (bf16*)(ws + WS_XA); float* rs1 = (float*)(ws + WS_RS1);
    for (int m0 = gw; m0 < MP + MS; m0 += 2 * NGW) {
        f32x4 v[2][8]; float s[2] = {0.f, 0.f};
#pragma unroll
        for (int q = 0; q < 2; ++q) { const int m = m0 + q * NGW; if (m < MP + MS) {
            const float* src = m < MP ? AR.in[0] + (size_t)m * DM : AR.in[1] + (size_t)(m - MP) * DM;
            const GAS f32x4* xr = (const GAS f32x4*)src + F.lane;
#pragma unroll
            for (int j = 0; j < 8; ++j) v[q][j] = xr[64 * j]; } }
#pragma unroll
        for (int q = 0; q < 2; ++q) { const int m = m0 + q * NGW; if (m < MP + MS) {
#pragma unroll
            for (int j = 0; j < 8; ++j) s[q] += (v[q][j].x * v[q][j].x + v[q][j].y * v[q][j].y) + (v[q][j].z * v[q][j].z + v[q][j].w * v[q][j].w);
            s[q] = wave_sum(s[q]);
            if (F.lane == 0) rs1[m] = 1.0f / sqrtf(s[q] * (1.0f / DM) + RMS_EPS);
            GAS unsigned long long* o8 = (GAS unsigned long long*)(XA + (size_t)m * DM) + F.lane;
#pragma unroll
            for (int j = 0; j < 8; ++j) o8[64 * j] = (unsigned long long)pk2(v[q][j].x, v[q][j].y) | ((unsigned long long)pk2(v[q][j].z, v[q][j].w) << 32); } }
    }
    const int gt = blockIdx.x * (NWAVES * 64) + F.tid, NGT = F.G * NWAVES * 64;
    float* ssq2 = (float*)(ws + WS_SSQ2); float* ssq3 = (float*)(ws + WS_SSQ3); float* ssq4 = (float*)(ws + WS_SSQ4);
    for (int i = gt; i < MPAD; i += NGT) { ssq2[i] = 0.f; ssq3[i] = 0.f; ssq4[i] = 0.f; }
    float* tbl = (float*)(ws + WS_TBL);
    for (int i = gt; i < NH * TBN; i += NGT) { const int h = i / TBN, j = i % TBN, d = 2048 - j; tbl[i] = d >= 0 ? t2_value(AR.in[19], h, d) : -__builtin_inff(); }
    bf16* wax = (bf16*)(ws + WS_WAX);
    for (int i = gt; i < 8 * 2 * 128 * 128; i += NGT) {
        const int j = i & 7, l = (i >> 3) & 63, kb = (i >> 9) & 3, w = (i >> 11) & 7, g = (i >> 14) & 1, n = i >> 15;
        const int k = 32 * kb + 8 * (l >> 4) + j, c = 16 * w + (l & 15);
        wax[i] = (bf16)f2bf((g ? AR.in[16] : AR.in[14])[((size_t)n * 128 + k) * 128 + c]);
    }
}

namespace at {
constexpr int SHM = 16384;
constexpr int TBW0 = 1504, TBWS = 834;
constexpr int V_OFF = 0, K_OFF = 2 * SHM, WSC_OFF = 4 * SHM, TB_OFF = WSC_OFF + 2048, FT_OFF = TB_OFF + 8 * TBWS * 4, LDS_END = FT_OFF + (132 + 196) * 4;
static_assert(LDS_END <= RING_BYTES, "attention lds");
#define KSWZ(row, colB) ((row) * 256 + ((colB) ^ (((row) & 7) << 4)))
__device__ __forceinline__ int v_st(int k, int c) { const int kk = (k & ~0xC) | ((k & 4) << 1) | ((k & 8) >> 1); return ((kk >> 3) * 4 + (c >> 5)) * 512 + ((kk & 7) * 32 + (c & 31)) * 2; }
__device__ __forceinline__ int v_rd_base(int lane) { return ((lane & 3) << 3) | (((lane >> 2) & 3) << 6) | (((lane >> 4) & 1) << 5) | (((lane >> 5) & 1) << 8); }
constexpr int v_rd_off(int d0, int ks, int half) { return d0 * 512 + ks * 4096 + half * 2048; }
__device__ __forceinline__ int crow(int r, int hi) { return (r & 3) + 8 * (r >> 2) + 4 * hi; }
__device__ __forceinline__ unsigned cvtpk(float lo, float hi) { unsigned r; asm volatile("v_cvt_pk_bf16_f32 %0, %1, %2" : "=v"(r) : "v"(lo), "v"(hi)); return r; }

constexpr float SM_THR = 11.0f;
__device__ __forceinline__ void partialSM(f32x16& p0, f32x16& p1, float& m_reg, float l_reg, float& delta, float& alpha) {
    float pmax = p0[0];
#pragma unroll
    for (int r = 1; r < 16; ++r) pmax = fmaxf(pmax, p0[r]);
#pragma unroll
    for (int r = 0; r < 16; ++r) pmax = fmaxf(pmax, p1[r]);
    { auto rr = __builtin_amdgcn_permlane32_swap(__float_as_uint(pmax), __float_as_uint(pmax), false, false);
      pmax = fmaxf(__uint_as_float(rr[0]), __uint_as_float(rr[1])); }
    const bool need = (pmax > SM_THR) || (l_reg == 0.f && pmax < -SM_THR && pmax > -__builtin_inff());
    if (!__any(need)) { delta = 0.f; alpha = 1.f;
#pragma unroll
        for (int r = 0; r < 16; ++r) p0[r] = __builtin_amdgcn_exp2f(p0[r]);
    } else { delta = need ? pmax : 0.f; alpha = __builtin_amdgcn_exp2f(-delta); m_reg += delta;
#pragma unroll
        for (int r = 0; r < 16; ++r) p0[r] = __builtin_amdgcn_exp2f(p0[r] - delta); }
}
__device__ __forceinline__ void finishSM(f32x16& p0, f32x16& p1, float delta, float alpha, float& l_reg, bf16x8& pa0, bf16x8& pa1, bf16x8& pa2, bf16x8& pa3) {
    if (__all(delta == 0.f)) {
#pragma unroll
        for (int r = 0; r < 16; ++r) p1[r] = __builtin_amdgcn_exp2f(p1[r]);
    } else {
#pragma unroll
        for (int r = 0; r < 16; ++r) p1[r] = __builtin_amdgcn_exp2f(p1[r] - delta); }
    float ps = 0;
#pragma unroll
    for (int r = 0; r < 16; ++r) ps += p0[r];
#pragma unroll
    for (int r = 0; r < 16; ++r) ps += p1[r];
    { auto rr = __builtin_amdgcn_permlane32_swap(__float_as_uint(ps), __float_as_uint(ps), false, false);
      ps = __uint_as_float(rr[0]) + __uint_as_float(rr[1]); }
    l_reg = l_reg * alpha + ps;
#define PK4(P, B_, OUT) do { unsigned a0 = cvtpk(P[B_+0], P[B_+1]), a1 = cvtpk(P[B_+2], P[B_+3]);                          \
        unsigned b0 = cvtpk(P[B_+4], P[B_+5]), b1 = cvtpk(P[B_+6], P[B_+7]);                                             \
        auto r0 = __builtin_amdgcn_permlane32_swap(a0, b0, false, false); auto r1 = __builtin_amdgcn_permlane32_swap(a1, b1, false, false); \
        v4u w = {r0[0], r1[0], r0[1], r1[1]}; OUT = __builtin_bit_cast(bf16x8, w); } while (0)
    PK4(p0, 0, pa0); PK4(p0, 8, pa1); PK4(p1, 0, pa2); PK4(p1, 8, pa3);
#undef PK4
}
template <int KB>
__device__ __forceinline__ void qkt(f32x16& p0, f32x16& p1, const LAS char* K_lds, int r32, int hi, const bf16x8* qr, const LAS float* tb, float mref) {
    unsigned ka[4];
#pragma unroll
    for (int dd = 0; dd < 4; ++dd) ka[dd] = (unsigned)(uintptr_t)(K_lds + KSWZ(r32, (dd * 16 + hi * 8) * 2));
#define KRD(dst, d0_, half_) asm volatile("ds_read_b128 %0, %1 offset:%2" : "=&v"(dst) : "v"(ka[(d0_) & 3]), "i"(KB * SHM + ((d0_) >> 2) * 128 + (half_) * 8192) : "memory")
#define KSTEP(d0_, cur_, nxt_, WAITN) do { if ((d0_) + 2 < 8) { KRD(kl[nxt_], (d0_) + 2, 0); KRD(kh[nxt_], (d0_) + 2, 1); } \
        asm volatile("s_waitcnt lgkmcnt(" #WAITN ")" ::: "memory"); __builtin_amdgcn_sched_barrier(0); \
        p0 = __builtin_amdgcn_mfma_f32_32x32x16_bf16(kl[cur_], qr[d0_], p0, 0, 0, 0); p1 = __builtin_amdgcn_mfma_f32_32x32x16_bf16(kh[cur_], qr[d0_], p1, 0, 0, 0); } while (0)
    bf16x8 kl[3], kh[3];
    KRD(kl[0], 0, 0); KRD(kh[0], 0, 1); KRD(kl[1], 1, 0); KRD(kh[1], 1, 1);
#pragma unroll
    for (int r = 0; r < 16; ++r) { const int c = (r & 3) + 8 * (r >> 2); p0[r] = tb[c] - mref; p1[r] = tb[c + 32] - mref; }
    asm volatile("s_waitcnt lgkmcnt(0)" ::: "memory"); __builtin_amdgcn_sched_barrier(0);
    KSTEP(0, 0, 2, 2); KSTEP(1, 1, 0, 2); KSTEP(2, 2, 1, 4); KSTEP(3, 0, 2, 4); KSTEP(4, 1, 0, 4); KSTEP(5, 2, 1, 4); KSTEP(6, 0, 2, 2); KSTEP(7, 1, 0, 0);
#undef KSTEP
#undef KRD
}
template <int VB>
__device__ __forceinline__ void pv_tile(f32x16* o, unsigned vb0, bf16x8 pa0, bf16x8 pa1, bf16x8 pa2, bf16x8 pa3) {
#define TRRD(dst, off) asm volatile("ds_read_b64_tr_b16 %0, %1 offset:%2" : "=&v"(dst) : "v"(vb0), "i"(off) : "memory")
#define PV_RD(S, d0) do { constexpr int b_ = VB * SHM + v_rd_off(d0, 0, 0); \
        TRRD(S[0], b_); TRRD(S[1], b_ + 2048); TRRD(S[2], b_ + 4096); TRRD(S[3], b_ + 6144); TRRD(S[4], b_ + 8192); TRRD(S[5], b_ + 10240); TRRD(S[6], b_ + 12288); TRRD(S[7], b_ + 14336); } while (0)
#define PV_MM(S, d0) do { \
        o[d0] = __builtin_amdgcn_mfma_f32_32x32x16_bf16(pa0, (bf16x8){S[0][0], S[0][1], S[0][2], S[0][3], S[1][0], S[1][1], S[1][2], S[1][3]}, o[d0], 0, 0, 0);   \
        o[d0] = __builtin_amdgcn_mfma_f32_32x32x16_bf16(pa1, (bf16x8){S[2][0], S[2][1], S[2][2], S[2][3], S[3][0], S[3][1], S[3][2], S[3][3]}, o[d0], 0, 0, 0);   \
        o[d0] = __builtin_amdgcn_mfma_f32_32x32x16_bf16(pa2, (bf16x8){S[4][0], S[4][1], S[4][2], S[4][3], S[5][0], S[5][1], S[5][2], S[5][3]}, o[d0], 0, 0, 0);   \
        o[d0] = __builtin_amdgcn_mfma_f32_32x32x16_bf16(pa3, (bf16x8){S[6][0], S[6][1], S[6][2], S[6][3], S[7][0], S[7][1], S[7][2], S[7][3]}, o[d0], 0, 0, 0); } while (0)
#define PV_WAIT(N) do { asm volatile("s_waitcnt lgkmcnt(" #N ")" ::: "memory"); __builtin_amdgcn_sched_barrier(0); } while (0)
    s16x4 A[8], B[8];
    PV_RD(A, 0);
    PV_RD(B, 1); PV_WAIT(8); PV_MM(A, 0);
    PV_RD(A, 2); PV_WAIT(8); PV_MM(B, 1);
    PV_RD(B, 3); PV_WAIT(8); PV_MM(A, 2);
    PV_WAIT(0); PV_MM(B, 3);
#undef PV_RD
#undef PV_MM
#undef PV_WAIT
#undef TRRD
}
__device__ __forceinline__ void far_softmax(f32x16& p0, float& m_reg, float& l_reg, float& alpha, bf16x8& pa0, bf16x8& pa1) {
    float pmax = p0[0];
#pragma unroll
    for (int r = 1; r < 16; ++r) pmax = fmaxf(pmax, p0[r]);
    { auto rr = __builtin_amdgcn_permlane32_swap(__float_as_uint(pmax), __float_as_uint(pmax), false, false);
      pmax = fmaxf(__uint_as_float(rr[0]), __uint_as_float(rr[1])); }
    const bool need = (pmax > SM_THR) || (l_reg == 0.f && pmax < -SM_THR && pmax > -__builtin_inff());
    float delta = 0.f; alpha = 1.f;
    if (__any(need)) { delta = need ? pmax : 0.f; alpha = __builtin_amdgcn_exp2f(-delta); m_reg += delta; }
    float ps = 0.f;
#pragma unroll
    for (int r = 0; r < 16; ++r) { p0[r] = __builtin_amdgcn_exp2f(p0[r] - delta); ps += p0[r]; }
    { auto rr = __builtin_amdgcn_permlane32_swap(__float_as_uint(ps), __float_as_uint(ps), false, false);
      ps = __uint_as_float(rr[0]) + __uint_as_float(rr[1]); }
    l_reg = l_reg * alpha + ps;
#define PK4(P, B_, OUT) do { unsigned a0 = cvtpk(P[B_+0], P[B_+1]), a1 = cvtpk(P[B_+2], P[B_+3]);                          \
        unsigned b0 = cvtpk(P[B_+4], P[B_+5]), b1 = cvtpk(P[B_+6], P[B_+7]);                                             \
        auto r0 = __builtin_amdgcn_permlane32_swap(a0, b0, false, false); auto r1 = __builtin_amdgcn_permlane32_swap(a1, b1, false, false); \
        v4u w = {r0[0], r1[0], r0[1], r1[1]}; OUT = __builtin_bit_cast(bf16x8, w); } while (0)
    PK4(p0, 0, pa0); PK4(p0, 8, pa1);
#undef PK4
}
}

__device__ __forceinline__ void attn_unit(Frame& F, int b, int h, int qb) {
    using namespace at;
    int tid = F.tid, lane = F.lane; asm volatile("" : "+v"(tid), "+v"(lane));
    const int wid = F.wave, r32 = lane & 31, hi = lane >> 5;
    LAS char* V_lds = (LAS char*)F.lds + V_OFF; LAS char* K_lds = (LAS char*)F.lds + K_OFF;
    LAS float* wsc = (LAS float*)(F.lds + WSC_OFF) + wid * 64; LAS float* li_l = wsc; LAS float* al_l = wsc + 32;
    LAS float* TB = (LAS float*)(F.lds + TB_OFF);
    const int P0 = qb * 256, NT = 4 * (qb + 1), rowbase = b * SP;
    const float* gt = (const float*)(F.ws + WS_TBL) + h * TBN;
    for (int i = tid; i < 8 * TBWS; i += NWAVES * 64) { const int k = i / TBWS, e_ = i - k * TBWS; TB[i] = gt[TBW0 + e_ - 32 * k]; }
    LAS float* FT = (LAS float*)(F.lds + FT_OFF);
    for (int i = tid; i < 129; i += NWAVES * 64) FT[i] = gt[2048 - 16 * i];
    LAS float* FT4 = FT + 132;
    for (int i = tid; i < 196; i += NWAVES * 64) FT4[i] = gt[2048 - 4 * i];
    const int qrow = 16 * (r32 & 15) + 2 * wid + (r32 >> 4), qpos = P0 + qrow;
    const bf16* Qp = (const bf16*)(F.ws + WS_Q) + (size_t)(rowbase + qpos) * AW + h * HD + hi * 8;
    bf16x8 qr[8];
#pragma unroll
    for (int d0 = 0; d0 < 8; ++d0) qr[d0] = *(const bf16x8*)(Qp + d0 * 16);
    float m_reg = 0.f, l_reg = 0.f; f32x16 o[4] = {};
    f32x16 p0, p1; float mn, alpha; bf16x8 pa0, pa1, pa2, pa3;
#define A_RESC() do { if (__any(alpha < 1.f)) { if (hi == 0) al_l[r32] = alpha; LDS_WAIT(); \
            _Pragma("unroll") for (int d_ = 0; d_ < 4; ++d_) _Pragma("unroll") for (int r = 0; r < 16; ++r) o[d_][r] *= al_l[crow(r, hi)]; } } while (0)
    __syncthreads();
    if (qb >= 3) {
        LAS char* fv = (LAS char*)F.lds + wid * 8192;
        const unsigned fvb = (unsigned)(uintptr_t)fv + (unsigned)v_rd_base(lane);
        const int eq = r32 >> 4;
        const bf16* Kf = (const bf16*)(F.ws + WS_KB) + (size_t)(rowbase + 16 * (r32 & 15) + 2 * wid + (r32 >> 4)) * AW + h * HD + hi * 8;
        const bf16* Vf = (const bf16*)(F.ws + WS_VB) + (size_t)(rowbase + 2 * wid) * AW + h * HD;
        const LAS float* tbf = FT + (16 * qb + (r32 & 15) - 4 * hi);
        bf16x8 kf[8], vch[8];
#define FAR_LOADK(f_) do { _Pragma("unroll") for (int d0 = 0; d0 < 8; ++d0) kf[d0] = *(const bf16x8*)(Kf + (size_t)(256 * (f_)) * AW + d0 * 16); } while (0)
#define FAR_LOADV(f_) do { _Pragma("unroll") for (int i = 0; i < 8; ++i) { const int q = lane + 64 * i, rho = q >> 4, chn = q & 15; \
                vch[i] = *(const bf16x8*)(Vf + (size_t)(256 * (f_) + 16 * (rho & 15) + (rho >> 4)) * AW + 8 * chn); } } while (0)
        FAR_LOADK(0); FAR_LOADV(0);
        for (int f = 0; f < qb - 2; ++f) {
#pragma unroll
            for (int r = 0; r < 8; ++r) { const int kk0 = (r & 3) + 8 * ((r >> 2) & 1); const float bias = tbf[-16 * f - kk0] - m_reg;
                p0[r] = (eq == 0) ? bias : -__builtin_inff();
                p0[r + 8] = (eq == 1) ? bias : -__builtin_inff(); }
#pragma unroll
            for (int d0 = 0; d0 < 8; ++d0) p0 = __builtin_amdgcn_mfma_f32_32x32x16_bf16(kf[d0], qr[d0], p0, 0, 0, 0);
            asm volatile("" : "+v"(p0));
            if (f + 1 < qb - 2) FAR_LOADK(f + 1);
#pragma unroll
            for (int i = 0; i < 8; ++i) { const int q = lane + 64 * i, rho = q >> 4, chn = q & 15; *(LAS bf16x8*)(fv + v_st(rho, 8 * chn)) = vch[i]; }
            asm volatile("" ::: "memory");
            if (f + 1 < qb - 2) FAR_LOADV(f + 1);
            far_softmax(p0, m_reg, l_reg, alpha, pa0, pa1);
            A_RESC();
            LDS_WAIT();
#define TRRD(dst, off) asm volatile("ds_read_b64_tr_b16 %0, %1 offset:%2" : "=&v"(dst) : "v"(fvb), "i"(off) : "memory")
#define FPV(d0) do { s16x4 l0, h0, l1, h1; constexpr int b_ = v_rd_off(d0, 0, 0); TRRD(l0, b_); TRRD(h0, b_ + 2048); TRRD(l1, b_ + 4096); TRRD(h1, b_ + 6144); \
                asm volatile("s_waitcnt lgkmcnt(0)" ::: "memory"); __builtin_amdgcn_sched_barrier(0); \
                o[d0] = __builtin_amdgcn_mfma_f32_32x32x16_bf16(pa0, (bf16x8){l0[0], l0[1], l0[2], l0[3], h0[0], h0[1], h0[2], h0[3]}, o[d0], 0, 0, 0); \
                o[d0] = __builtin_amdgcn_mfma_f32_32x32x16_bf16(pa1, (bf16x8){l1[0], l1[1], l1[2], l1[3], h1[0], h1[1], h1[2], h1[3]}, o[d0], 0, 0, 0); } while (0)
            FPV(0); FPV(1); FPV(2); FPV(3);
#undef FPV
#undef TRRD
        }
#undef FAR_LOADK
#undef FAR_LOADV
    }
    __syncthreads();
    const int kb_lo = P0 > 512 ? P0 - 512 : 0;
    const int nmid = P0 >= 128 ? (P0 - 128 - kb_lo) >> 6 : 0;
    const int t_lo = qb >= 1 ? 4 * qb - 2 : 0;
    const int sr = tid >> 4, sc = (tid & 15) * 8, vst0 = v_st(sr, sc), vst1 = v_st(32 + sr, sc), kws = KSWZ(sr, sc * 2), mra = 4 * (sr & 15) + (sr >> 4);
    const bf16* Kp = (const bf16*)(F.ws + WS_KB) + (size_t)rowbase * AW + h * HD + sc;
    const bf16* Vp = (const bf16*)(F.ws + WS_VB) + (size_t)rowbase * AW + h * HD + sc;
    bf16x8 st_k0, st_k1, st_v0, st_v1;
#define A_LOAD(n_) do { const int n__ = (n_); const bool md_ = n__ < nmid; const int kb_ = md_ ? kb_lo + 64 * n__ : 64 * (t_lo + n__ - nmid); \
                         const int ra_ = kb_ + (md_ ? mra : sr), rb_ = kb_ + (md_ ? mra + 2 : sr + 32); \
                         st_k0 = *(const bf16x8*)(Kp + (size_t)ra_ * AW); st_k1 = *(const bf16x8*)(Kp + (size_t)rb_ * AW); \
                         st_v0 = *(const bf16x8*)(Vp + (size_t)ra_ * AW); st_v1 = *(const bf16x8*)(Vp + (size_t)rb_ * AW); } while (0)
#define A_WRITE(bf) do { *(LAS bf16x8*)(K_lds + (bf) * SHM + kws) = st_k0; *(LAS bf16x8*)(K_lds + (bf) * SHM + kws + 32 * 256) = st_k1; \
                         *(LAS bf16x8*)(V_lds + (bf) * SHM + vst0) = st_v0; *(LAS bf16x8*)(V_lds + (bf) * SHM + vst1) = st_v1; } while (0)
    A_LOAD(0); A_WRITE(0);
    __syncthreads();
    const unsigned vb0 = (unsigned)(uintptr_t)V_lds + (unsigned)v_rd_base(lane);
    int n = 0;
    if (nmid > 0) {
        const int eq = r32 >> 4, c0 = (2 * wid) & 3, c1 = (2 * wid + 1) & 3;
        const int rowsel = 16 * (eq ? c1 : c0) + (r32 & 15);
        int kam[4];
#pragma unroll
        for (int dd = 0; dd < 4; ++dd) kam[dd] = KSWZ(rowsel, (dd * 16 + hi * 8) * 2);
        const unsigned vbm0 = vb0 + 4096u * (unsigned)c0, vbm1 = vb0 + 4096u * (unsigned)c1;
        const LAS float* tbm = FT4 + ((P0 - kb_lo) / 4 + 4 * (r32 & 15) + ((2 * wid + eq) >> 2) - 4 * hi);
#define TRRD(dst, base, off) asm volatile("ds_read_b64_tr_b16 %0, %1 offset:%2" : "=&v"(dst) : "v"(base), "i"(off) : "memory")
#define MPV(bf, d0) do { s16x4 l0, h0, l1, h1; constexpr int b_ = (bf) * SHM + v_rd_off(d0, 0, 0); TRRD(l0, vbm0, b_); TRRD(h0, vbm0, b_ + 2048); TRRD(l1, vbm1, b_); TRRD(h1, vbm1, b_ + 2048); \
            asm volatile("s_waitcnt lgkmcnt(0)" ::: "memory"); __builtin_amdgcn_sched_barrier(0); \
            o[d0] = __builtin_amdgcn_mfma_f32_32x32x16_bf16(pa0, (bf16x8){l0[0], l0[1], l0[2], l0[3], h0[0], h0[1], h0[2], h0[3]}, o[d0], 0, 0, 0); \
            o[d0] = __builtin_amdgcn_mfma_f32_32x32x16_bf16(pa1, (bf16x8){l1[0], l1[1], l1[2], l1[3], h1[0], h1[1], h1[2], h1[3]}, o[d0], 0, 0, 0); } while (0)
#define M_STEP(n_, bf) do { \
            A_LOAD((n_) + 1);                                   \
            bf16x8 kf[8]; \
            _Pragma("unroll") for (int d0 = 0; d0 < 8; ++d0) kf[d0] = *(const LAS bf16x8*)(K_lds + (bf) * SHM + kam[d0 & 3] + (d0 >> 2) * 128); \
            _Pragma("unroll") for (int r = 0; r < 8; ++r) { const int kk0 = (r & 3) + 8 * ((r >> 2) & 1); const float bias = tbm[-16 * (n_) - kk0] - m_reg; \
                p0[r] = (eq == 0) ? bias : -__builtin_inff(); p0[r + 8] = (eq == 1) ? bias : -__builtin_inff(); } \
            _Pragma("unroll") for (int d0 = 0; d0 < 8; ++d0) p0 = __builtin_amdgcn_mfma_f32_32x32x16_bf16(kf[d0], qr[d0], p0, 0, 0, 0); \
            far_softmax(p0, m_reg, l_reg, alpha, pa0, pa1); \
            A_RESC(); \
            MPV(bf, 0); MPV(bf, 1); MPV(bf, 2); MPV(bf, 3); \
            A_WRITE((bf) ^ 1); \
            __syncthreads(); } while (0)
        for (; n < nmid; n += 2) { M_STEP(n, 0); M_STEP(n + 1, 1); }
#undef M_STEP
#undef MPV
#undef TRRD
    }
    const LAS float* tbq = TB + ((r32 & 15) >> 1) * TBWS + (2048 - P0 - 2 * wid - (r32 >> 4) + 4 * hi - TBW0 - 16 * (r32 & 1));
#define A_STEP(n_, t, bf) do { \
        if ((t) + 1 < NT) A_LOAD((n_) + 1); \
        qkt<bf>(p0, p1, K_lds, r32, hi, qr, tbq + (t) * 64, m_reg); \
        partialSM(p0, p1, m_reg, l_reg, mn, alpha);        \
        A_RESC(); \
        finishSM(p0, p1, mn, alpha, l_reg, pa0, pa1, pa2, pa3); \
        pv_tile<bf>(o, vb0, pa0, pa1, pa2, pa3); \
        if ((t) + 1 < NT) A_WRITE((bf) ^ 1); \
        __syncthreads(); } while (0)
    for (int t = t_lo; t < NT; t += 2, n += 2) { A_STEP(n, t, 0); A_STEP(n + 1, t + 1, 1); }
#undef A_STEP
#undef A_LOAD
#undef A_WRITE
#undef A_RESC
    if (hi == 0) li_l[r32] = l_reg;
    LDS_WAIT();
    bf16* Ow = (bf16*)(F.ws + WS_GRP) + (size_t)(rowbase + P0 + 2 * wid) * DM + h * HD;
    float* ssqa = (float*)(F.ws + WS_SSQA) + (size_t)(rowbase + P0 + 2 * wid) * 8 + h;
#pragma unroll
    for (int r = 0; r < 16; ++r) {
        const int rr = crow(r, hi), orow = 16 * (rr & 15) + (rr >> 4); const float rl = 1.0f / li_l[rr]; float sq = 0.f;
#pragma unroll
        for (int d0 = 0; d0 < 4; ++d0) { const float v = o[d0][r] * rl; sq += v * v; const float vn = dppf<0xB1>(v);
            if ((r32 & 1) == 0) *(unsigned*)(Ow + (size_t)orow * DM + d0 * 32 + r32) = cvtpk(v, vn); }
        sq = sum16(sq); sq = sum_r16(sq);
        if (r32 == 0) ssqa[(size_t)orow * 8] = sq;
    }
    __syncthreads();
}

__device__ __forceinline__ void sattn_prefetch(Frame& F, const Args& AR, int b, int h) {
    const float* ck = AR.in[2]; const float* cv = AR.in[3];
    for (int i = F.tid; i < 321 * 32; i += NWAVES * 64) {
        const int di = i >> 5, t = (i >> 3) & 3, ln = (i >> 1) & 3, kv = i & 1;
        const int d = di < 129 ? di : (di < 225 ? 128 + 4 * (di - 128) : 512 + 16 * (di - 224));
        const int pos = 2048 + t - d;
        if (pos < 2048) { const float* p = (kv ? cv : ck) + (((size_t)b * 2048 + pos) * NH + h) * HD + 32 * ln;
            __builtin_amdgcn_global_load_lds((const unsigned*)p, (LAS unsigned*)(F.lds + 114688 + F.wave * 256), 4, 0, 0); }
    }
}
__device__ __forceinline__ void sattn_unit(Frame& F, const Args& AR, int b, int h) {
    int lane = F.lane; asm volatile("" : "+v"(lane));
    const int wid = F.wave, t = lane >> 4, seg = lane & 15;
    const int row = MP + TS * b + t;
    const bf16* qp = (const bf16*)(F.ws + WS_Q) + (size_t)row * AW + h * HD + 8 * seg;
    float qf[8];
    { const v4u qv = *(const v4u*)qp; const unsigned qw[4] = {qv.x, qv.y, qv.z, qv.w};
#pragma unroll
      for (int j = 0; j < 4; ++j) { qf[2 * j] = bf2f((unsigned short)(qw[j] & 0xffffu)); qf[2 * j + 1] = bf2f((unsigned short)(qw[j] >> 16)); } }
    const float* ck = AR.in[2]; const float* cv = AR.in[3];
    const float* gt = (const float*)(F.ws + WS_TBL) + h * TBN;
    float m = -1e30f, l = 0.f, acc[8];
#pragma unroll
    for (int j = 0; j < 8; ++j) acc[j] = 0.f;
#define SA_LOAD(K0, K1, V0, V1, TB_, di_raw_, valid_) do { const int di = (di_raw_); \
            const int d = di < 129 ? di : (di < 225 ? 128 + 4 * (di - 128) : 512 + 16 * (di - 224)); \
            const int i = 2048 + t - d; \
            const float* kp; const float* vp; \
            if (i < 2048) { const size_t off = (((size_t)b * 2048 + i) * NH + h) * HD + 8 * seg; kp = ck + off; vp = cv + off; } \
            else { const size_t off = (size_t)(TS * b + (i - 2048)) * AW + h * HD + 8 * seg; kp = F.out + OFF_KS + off; vp = F.out + OFF_VS + off; } \
            K0 = *(const f32x4*)kp; K1 = *(const f32x4*)(kp + 4); V0 = *(const f32x4*)vp; V1 = *(const f32x4*)(vp + 4); \
            TB_ = (valid_) ? gt[2048 - d] : -__builtin_inff(); } while (0)
#define SA_ACC(K0, K1, V0, V1, TB_) do { \
            float dot = ((qf[0] * K0[0] + qf[1] * K0[1]) + (qf[2] * K0[2] + qf[3] * K0[3])) + ((qf[4] * K1[0] + qf[5] * K1[1]) + (qf[6] * K1[2] + qf[7] * K1[3])); \
            dot = sum16(dot); \
            const float s2 = dot + TB_;                                      \
            const float mn = fmaxf(m, s2), al = __builtin_amdgcn_exp2f(m - mn), p = __builtin_amdgcn_exp2f(s2 - mn); \
            l = l * al + p; m = mn; \
            _Pragma("unroll") for (int j = 0; j < 4; ++j) { acc[j] = acc[j] * al + p * V0[j]; acc[4 + j] = acc[4 + j] * al + p * V1[j]; } } while (0)
    f32x4 ke0, ke1, ve0, ve1; float tbe;
    SA_LOAD(ke0, ke1, ve0, ve1, tbe, 320, wid == 0);
    for (int k0 = 0; k0 < 40; k0 += 8) {
        f32x4 k0v[8], k1v[8], v0v[8], v1v[8]; float tb[8];
#pragma unroll
        for (int u = 0; u < 8; ++u) SA_LOAD(k0v[u], k1v[u], v0v[u], v1v[u], tb[u], wid + NWAVES * (k0 + u), true);
#pragma unroll
        for (int u = 0; u < 8; ++u) SA_ACC(k0v[u], k1v[u], v0v[u], v1v[u], tb[u]);
    }
    SA_ACC(ke0, ke1, ve0, ve1, tbe);
#undef SA_LOAD
#undef SA_ACC
    LAS float* sm = (LAS float*)F.lds;
    { LAS float* s = sm + (wid * 64 + lane) * 10; s[0] = m; s[1] = l;
#pragma unroll
      for (int j = 0; j < 8; ++j) s[2 + j] = acc[j]; }
    __syncthreads();
    if (wid == 0) {
        float M = -1e30f;
#pragma unroll
        for (int w = 0; w < NWAVES; ++w) M = fmaxf(M, sm[(w * 64 + lane) * 10]);
        float L = 0.f, O[8];
#pragma unroll
        for (int j = 0; j < 8; ++j) O[j] = 0.f;
#pragma unroll
        for (int w = 0; w < NWAVES; ++w) { const LAS float* s = sm + (w * 64 + lane) * 10; const float e = __builtin_amdgcn_exp2f(s[0] - M); L += s[1] * e;
#pragma unroll
            for (int j = 0; j < 8; ++j) O[j] += s[2 + j] * e; }
        const float rl = 1.0f / L; float sq = 0.f;
#pragma unroll
        for (int j = 0; j < 8; ++j) { O[j] *= rl; sq += O[j] * O[j]; }
        v4u w4; w4.x = pk2(O[0], O[1]); w4.y = pk2(O[2], O[3]); w4.z = pk2(O[4], O[5]); w4.w = pk2(O[6], O[7]);
        *(v4u*)((bf16*)(F.ws + WS_GRP) + (size_t)row * DM + h * HD + 8 * seg) = w4;
        sq = sum16(sq);
        if (seg == 0) ((float*)(F.ws + WS_SSQA))[(size_t)row * 8 + h] = sq;
    }
    __syncthreads();
}

namespace lru {
constexpr int TS_ = 272;
constexpr int UB_OFF = 0, GT_OFF = 2 * 64 * TS_  , YT_OFF = 4 * 64 * TS_  , LDS_END = 6 * 64 * TS_;
static_assert(LDS_END <= RING_BYTES, "lru lds");
}
__device__ __forceinline__ void lru_unit(Frame& F, const Args& AR, int rowbase, int T, int n, const float* prefix, const float* h0, float* conv_out, float* h_out) {
    using namespace lru;
    int tid = F.tid, l = F.lane; asm volatile("" : "+v"(tid), "+v"(l));
    const int w = F.wave, cl = l & 15, tq = l >> 4;
    const int chl = 16 * w + cl, ch = 128 * n + chl;
    const float ba2 = AR.in[15][ch] * -LOG2E, bx2 = AR.in[17][ch] * -LOG2E;
    const float lam = AR.in[18][ch];
    const float LA2 = -8.0f * log1pf(expf(-lam)) * LOG2E;
    float hc = h0 ? h0[ch] : 0.f;
    bf16x8 bfa[4], bfx[4];
    { const bf16* wax = (const bf16*)(F.ws + WS_WAX);
#pragma unroll
      for (int kb = 0; kb < 4; ++kb) { bfa[kb] = *(const bf16x8*)(wax + ((size_t)((((n * 2 + 0) * 8 + w) * 4 + kb) * 64 + l)) * 8);
                                       bfx[kb] = *(const bf16x8*)(wax + ((size_t)((((n * 2 + 1) * 8 + w) * 4 + kb) * 64 + l)) * 8); } }
    const int c4 = tid & 31, tr = tid >> 5;
    const int cg = 128 * n + 4 * c4;
    f32x4 cw[4];
#pragma unroll
    for (int j = 0; j < 4; ++j) cw[j] = *(const f32x4*)(AR.in[12] + j * AW + cg);
    const f32x4 cb = *(const f32x4*)(AR.in[13] + cg);
    const bf16* XL = (const bf16*)(F.ws + WS_XL);
    const bf16* GG = (const bf16*)(F.ws + WS_GG);
    bf16* YL = (bf16*)(F.ws + WS_GRP) + AW;
    float* ssql = (float*)(F.ws + WS_SSQL);
    const int io_row = tid >> 4, io_c8 = (tid & 15) * 8;
    f32x4 x[7]; v4u gch[2];
    const bf16* xlp = XL + ((size_t)rowbase + 4 * tr - 3) * AW + cg;
    const bf16* ggp = GG + ((size_t)rowbase + io_row) * AW + 128 * n + io_c8;
    bf16* ylp = YL + ((size_t)rowbase + io_row) * DM + 128 * n + io_c8;
    float* sqp = ssql + ((size_t)rowbase + io_row) * 8 + n;
#define LRU_X4(w_) ((f32x4){__builtin_bit_cast(float, (w_).x << 16), __builtin_bit_cast(float, (w_).x & 0xffff0000u), __builtin_bit_cast(float, (w_).y << 16), __builtin_bit_cast(float, (w_).y & 0xffff0000u)})
#define LRU_LOADX(sc_) do { if ((sc_) >= 64 && (sc_) + 64 <= T) {              \
            _Pragma("unroll") for (int r = 0; r < 7; ++r) { const v2u w_ = *(const v2u*)(xlp + (size_t)((sc_) + r) * AW); x[r] = LRU_X4(w_); } \
            gch[0] = *(const v4u*)(ggp + (size_t)(sc_) * AW); gch[1] = *(const v4u*)(ggp + (size_t)((sc_) + 32) * AW); \
        } else { \
            _Pragma("unroll") for (int r = 0; r < 7; ++r) { const int tt = (sc_) + 4 * tr - 3 + r; \
                if (tt < 0) x[r] = prefix ? *(const f32x4*)(prefix + (3 + tt) * AW + cg) : (f32x4){0.f, 0.f, 0.f, 0.f}; \
                else if (tt < T) { const v2u w_ = *(const v2u*)(xlp + (size_t)((sc_) + r) * AW); x[r] = LRU_X4(w_); } \
                else x[r] = (f32x4){0.f, 0.f, 0.f, 0.f}; } \
            _Pragma("unroll") for (int k = 0; k < 2; ++k) { const int t_ = (sc_) + io_row + 32 * k; gch[k] = t_ < T ? *(const v4u*)(ggp + (size_t)((sc_) + 32 * k) * AW) : (v4u){0u, 0u, 0u, 0u}; } } } while (0)
#define LRU_CONVW(buf_, sc_) do { LAS unsigned char* UBw = F.lds + UB_OFF + (buf_) * 64 * TS_; LAS unsigned char* GTw = F.lds + GT_OFF + (buf_) * 64 * TS_; \
        _Pragma("unroll") for (int i = 0; i < 4; ++i) { const int tl = 4 * tr + i; \
            const f32x4 u = cb + cw[0] * x[i] + cw[1] * x[i + 1] + cw[2] * x[i + 2] + cw[3] * x[i + 3]; \
            v2u ub; ub.x = pg8::cvt_pk_bf16(u[0], u[1]); ub.y = pg8::cvt_pk_bf16(u[2], u[3]); \
            *(LAS v2u*)(UBw + tl * TS_ + 8 * c4) = ub; } \
        if ((sc_) + 64 >= T) { _Pragma("unroll") for (int i = 0; i < 4; ++i) { const int t = (sc_) + 4 * tr + i; if (t < T && t >= T - 3) *(f32x4*)(conv_out + (t - (T - 3)) * AW + cg) = x[i + 3]; } } \
        _Pragma("unroll") for (int k = 0; k < 2; ++k) *(LAS v4u*)(GTw + (io_row + 32 * k) * TS_ + 2 * io_c8) = gch[k]; } while (0)
#define LRU_FLUSH(buf_, sc_) do { const LAS unsigned char* YTr = F.lds + YT_OFF + (buf_) * 64 * TS_; \
        _Pragma("unroll") for (int k = 0; k < 2; ++k) { const int row_ = io_row + 32 * k, t_ = (sc_) + row_; const v4u yv = *(const LAS v4u*)(YTr + row_ * TS_ + 2 * io_c8); \
            const unsigned yw[4] = {yv.x, yv.y, yv.z, yv.w}; float sq = 0.f; \
            _Pragma("unroll") for (int j = 0; j < 4; ++j) { const float a_ = __builtin_bit_cast(float, yw[j] << 16), b_ = __builtin_bit_cast(float, yw[j] & 0xffff0000u); sq += a_ * a_ + b_ * b_; } \
            sq = sum16(sq); \
            if (t_ < T) { *(v4u*)(ylp + (size_t)((sc_) + 32 * k) * DM) = yv; if ((tid & 15) == 0) sqp[(size_t)((sc_) + 32 * k) * 8] = sq; } } } while (0)
    const int nsc = (T + 63) >> 6;
    float hlast = 0.f;
    LRU_LOADX(0); LRU_CONVW(0, 0);
    __syncthreads();
    for (int s = 0; s < nsc; ++s) {
        const int sc = 64 * s, cur = s & 1;
        const bool more = s + 1 < nsc, lastsc = !more;
        if (more) LRU_LOADX(sc + 64);
        if (s > 0) LRU_FLUSH(cur ^ 1, sc - 64);
        const LAS unsigned char* UB = F.lds + UB_OFF + cur * 64 * TS_; const LAS unsigned char* GT = F.lds + GT_OFF + cur * 64 * TS_;
        LAS unsigned char* YT = F.lds + YT_OFF + cur * 64 * TS_;
        f32x4 accA[4], accX[4];
#pragma unroll
        for (int rt = 0; rt < 4; ++rt) { accA[rt] = (f32x4){0.f, 0.f, 0.f, 0.f}; accX[rt] = (f32x4){0.f, 0.f, 0.f, 0.f};
#pragma unroll
            for (int kb = 0; kb < 4; ++kb) { const bf16x8 a = *(const LAS bf16x8*)(UB + (16 * rt + cl) * TS_ + (32 * kb + 8 * tq) * 2);
                accA[rt] = __builtin_amdgcn_mfma_f32_16x16x32_bf16(a, bfa[kb], accA[rt], 0, 0, 0);
                accX[rt] = __builtin_amdgcn_mfma_f32_16x16x32_bf16(a, bfx[kb], accX[rt], 0, 0, 0); } }
#pragma unroll
        for (int rt = 0; rt < 4; ++rt) {
            float av[4], bv[4], gv[4];
#pragma unroll
            for (int i = 0; i < 4; ++i) { const int tl = 16 * rt + 4 * tq + i;
                const float ra = pg8::fast_rcp(1.0f + pg8::fast_exp2(fmaf(accA[rt][i], -LOG2E, ba2))), ix = pg8::fast_rcp(1.0f + pg8::fast_exp2(fmaf(accX[rt][i], -LOG2E, bx2)));
                const float a = __builtin_amdgcn_exp2f(ra * LA2);
                const float mult = __builtin_amdgcn_sqrtf(fmaxf(fmaf(-a, a, 1.0f), 0.f));
                const float uf = bf2f(*(const LAS unsigned short*)(UB + tl * TS_ + 2 * chl));
                gv[i] = bf2f(*(const LAS unsigned short*)(GT + tl * TS_ + 2 * chl));
                av[i] = a; bv[i] = mult * ix * uf; }
            float A = av[0], B = bv[0];
#pragma unroll
            for (int i = 1; i < 4; ++i) { B = B * av[i] + bv[i]; A = A * av[i]; }
            float Ag[4], Bg[4];
#pragma unroll
            for (int j = 0; j < 4; ++j) { Ag[j] = __builtin_bit_cast(float, __builtin_amdgcn_ds_bpermute((cl + 16 * j) << 2, __builtin_bit_cast(int, A))); Bg[j] = __builtin_bit_cast(float, __builtin_amdgcn_ds_bpermute((cl + 16 * j) << 2, __builtin_bit_cast(int, B))); }
            float hin = hc, hend = hc;
#pragma unroll
            for (int j = 0; j < 4; ++j) { if (j < tq) hin = Ag[j] * hin + Bg[j]; hend = Ag[j] * hend + Bg[j]; }
            float hh = hin, yv_[4];
#pragma unroll
            for (int i = 0; i < 4; ++i) { const int t = sc + 16 * rt + 4 * tq + i;
                hh = av[i] * hh + bv[i];
                if (lastsc) hlast = (t == T - 1) ? hh : hlast;
                yv_[i] = hh * gv[i]; }
            { const unsigned p01 = pg8::cvt_pk_bf16(yv_[0], yv_[1]), p23 = pg8::cvt_pk_bf16(yv_[2], yv_[3]);
              LAS unsigned char* yp = YT + (16 * rt + 4 * tq) * TS_ + 2 * chl;
              *(LAS unsigned short*)(yp) = (unsigned short)(p01 & 0xffffu); *(LAS unsigned short*)(yp + TS_) = (unsigned short)(p01 >> 16);
              *(LAS unsigned short*)(yp + 2 * TS_) = (unsigned short)(p23 & 0xffffu); *(LAS unsigned short*)(yp + 3 * TS_) = (unsigned short)(p23 >> 16); }
            hc = hend;
        }
        if (more) LRU_CONVW(cur ^ 1, sc + 64);
        __syncthreads();
    }
    LRU_FLUSH((nsc - 1) & 1, 64 * (nsc - 1));
    { const int tl_last = (T - 1) - 64 * (nsc - 1); if ((tl_last >> 2 & 3) == tq) h_out[ch] = hlast; }
    __syncthreads();
#undef LRU_LOADX
#undef LRU_CONVW
#undef LRU_FLUSH
#undef LRU_X4
}

enum { SK_SWIGLU = 0, SK_RES = 1, SK_IN = 2, SK_OUT = 3 };
struct SkP {
    const bf16* A; int lda; const bf16* B; int ldb; int K; int ncg;
    const float* rs; const float* ssq_in;
    bf16* Hout;
    const float* base; bf16* xa; float* ssq_out; float coef;
    bf16* Q; bf16* Kb; bf16* Vb; bf16* GG; bf16* XL; float* out;
};
template <int KIND>
__device__ __forceinline__ void skinny_phase(Frame& F, const SkP& P, const float* sca = nullptr, const float* scl = nullptr) {
    int l = F.lane, tid = F.tid; asm volatile("" : "+v"(l), "+v"(tid));
    const int w = F.wave, lr = l & 15, lq = l >> 4;
    constexpr int NB = KIND == SK_SWIGLU ? 2 : 1;
    constexpr int CGN = (KIND == SK_SWIGLU || KIND == SK_IN) ? 3 : 1;
    constexpr int BSTEP = CGN == 3 ? 1 : 2, DEPTH = 3;
    constexpr int NBF = CGN * NB;
    LAS float* red = (LAS float*)F.lds;
    const int half_g = F.G >> 1, kw = P.K / 8, nbat = kw / (32 * BSTEP);
    const int rh = blockIdx.x & 1, cg0 = blockIdx.x >> 1;
    if (cg0 < P.ncg) {
        bool cgv[CGN]; const bf16* Bb[NBF];
#pragma unroll
        for (int j = 0; j < CGN; ++j) { const int cg = cg0 + j * half_g; cgv[j] = cg < P.ncg; const int c0 = 16 * (cgv[j] ? cg : cg0);
            int brow = c0 + lr; if (KIND == SK_SWIGLU) brow = 256 * (c0 >> 7) + (c0 & 127) + lr;
            Bb[j * NB] = P.B + (size_t)brow * P.ldb + w * kw + 8 * lq; if (NB == 2) Bb[j * NB + NB - 1] = Bb[j * NB] + (size_t)128 * P.ldb; }
        const bf16* Ab = P.A + (size_t)(64 * rh + lr) * P.lda + w * kw + 8 * lq;
        const size_t rstep = (size_t)16 * P.lda;
        pg8::f32x4 acc[4][NBF];
#pragma unroll
        for (int rt = 0; rt < 4; ++rt)
#pragma unroll
            for (int q = 0; q < NBF; ++q) acc[rt][q] = (pg8::f32x4){0.f, 0.f, 0.f, 0.f};
        bf16x8 ra[DEPTH][BSTEP][4], rb[DEPTH][BSTEP][NBF];
#define SK_LOAD(d_, b_) do { _Pragma("unroll") for (int u = 0; u < BSTEP; ++u) { const int k_ = ((b_) * BSTEP + u) * 32; \
            _Pragma("unroll") for (int rt = 0; rt < 4; ++rt) ra[d_][u][rt] = *(const bf16x8*)(Ab + rt * rstep + k_); \
            _Pragma("unroll") for (int q = 0; q < NBF; ++q) rb[d_][u][q] = *(const bf16x8*)(Bb[q] + k_); } } while (0)
#define SK_MMA(d_) do { _Pragma("unroll") for (int u = 0; u < BSTEP; ++u) _Pragma("unroll") for (int rt = 0; rt < 4; ++rt) _Pragma("unroll") for (int q = 0; q < NBF; ++q) \
            acc[rt][q] = __builtin_amdgcn_mfma_f32_16x16x32_bf16(rb[d_][u][q], ra[d_][u][rt], acc[rt][q], 0, 0, 0); } while (0)
        SK_LOAD(0, 0); if (1 < nbat) SK_LOAD(1, 1); if (2 < nbat) SK_LOAD(2, 2);
        for (int b = 0; b < nbat; b += 3) {
            SK_MMA(0); if (b + 3 < nbat) SK_LOAD(0, b + 3);
            if (b + 1 < nbat) { SK_MMA(1); if (b + 4 < nbat) SK_LOAD(1, b + 4); }
            if (b + 2 < nbat) { SK_MMA(2); if (b + 5 < nbat) SK_LOAD(2, b + 5); }
        }
#undef SK_LOAD
#undef SK_MMA
        if (KIND == SK_OUT) {
#pragma unroll
            for (int rt = 0; rt < 4; ++rt) { const int R = MP + 64 * rh + 16 * rt + lr; const float* sp = (w >= 4 ? scl : sca) + (size_t)R * 8;
                const pg8::f32x4 x = *(const pg8::f32x4*)sp, y = *(const pg8::f32x4*)(sp + 4);
                const float t = ((x[0] + x[1]) + (x[2] + x[3])) + ((y[0] + y[1]) + (y[2] + y[3])); acc[rt][0] = acc[rt][0] * (1.0f / sqrtf(t * (1.0f / AW) + RMS_EPS)); } }
#pragma unroll
        for (int j = 0; j < CGN; ++j) {
            if (!cgv[j]) continue;
            const int c0 = 16 * (cg0 + j * half_g);
#pragma unroll
            for (int rt = 0; rt < 4; ++rt)
#pragma unroll
                for (int nb = 0; nb < NB; ++nb) *(LAS pg8::f32x4*)(red + ((((nb * 8 + w) * 64) + 16 * rt + lr) * 4 + lq) * 4) = acc[rt][j * NB + nb];
            __syncthreads();
            if (tid < 256) {
                const int row = tid >> 2, qd = tid & 3, m = 64 * rh + row, R = MP + m, c = c0 + 4 * qd;
                pg8::f32x4 acc0 = {0.f, 0.f, 0.f, 0.f}, acc1 = {0.f, 0.f, 0.f, 0.f};
#pragma unroll
                for (int ww = 0; ww < 8; ++ww) { acc0 = acc0 + *(const LAS pg8::f32x4*)(red + (((ww * 64) + row) * 4 + qd) * 4); if (NB == 2) acc1 = acc1 + *(const LAS pg8::f32x4*)(red + ((((8 + ww) * 64) + row) * 4 + qd) * 4); }
                if (KIND == SK_SWIGLU) {
                    const float s = P.ssq_in ? 1.0f / sqrtf(P.ssq_in[R] * (1.0f / DM) + RMS_EPS) : P.rs[R];
                    float h[4];
#pragma unroll
                    for (int jj = 0; jj < 4; ++jj) h[jj] = pg8::silu_f(acc0[jj] * s) * (acc1[jj] * s);
                    v2u o; o.x = pg8::cvt_pk_bf16(h[0], h[1]); o.y = pg8::cvt_pk_bf16(h[2], h[3]);
                    *(v2u*)(P.Hout + (size_t)R * HLD + c) = o;
                } else if (KIND == SK_RES || KIND == SK_OUT) {
                    pg8::f32x4 b;
                    if (P.base) b = *(const pg8::f32x4*)(P.base + (size_t)m * DM + c);
                    else { const v2u wv = *(const v2u*)(P.xa + (size_t)R * DM + c);
                        b = (pg8::f32x4){__builtin_bit_cast(float, wv.x << 16), __builtin_bit_cast(float, wv.x & 0xffff0000u), __builtin_bit_cast(float, wv.y << 16), __builtin_bit_cast(float, wv.y & 0xffff0000u)}; }
                    const pg8::f32x4 x = b + acc0 * P.coef;
                    { v2u o; o.x = pg8::cvt_pk_bf16(x[0], x[1]); o.y = pg8::cvt_pk_bf16(x[2], x[3]); *(v2u*)(P.xa + (size_t)R * DM + c) = o;
                      float ss = (x[0] * x[0] + x[1] * x[1]) + (x[2] * x[2] + x[3] * x[3]); ss = sum_x1(ss); ss = sum_x2(ss);
                      if (qd == 0) __hip_atomic_fetch_add(P.ssq_out + R, ss, __ATOMIC_RELAXED, __HIP_MEMORY_SCOPE_AGENT); }
                } else {
                    const float s = 1.0f / sqrtf(P.ssq_in[R] * (1.0f / DM) + RMS_EPS);
                    pg8::f32x4 v = acc0 * s; const int seg = c0 >> 10, cs = (c0 & 1023) + 4 * qd;
                    v2u o; o.x = pg8::cvt_pk_bf16(v[0], v[1]); o.y = pg8::cvt_pk_bf16(v[2], v[3]);
                    if (seg == 0) { v2u oq; oq.x = pg8::cvt_pk_bf16(v[0] * ATT_C2, v[1] * ATT_C2); oq.y = pg8::cvt_pk_bf16(v[2] * ATT_C2, v[3] * ATT_C2); *(v2u*)(P.Q + (size_t)R * AW + cs) = oq; }
                    else if (seg == 1) { *(v2u*)(P.Kb + (size_t)R * AW + cs) = o; *(pg8::f32x4*)(P.out + OFF_KS + (size_t)m * AW + cs) = v; }
                    else if (seg == 2) { *(v2u*)(P.Vb + (size_t)R * AW + cs) = o; *(pg8::f32x4*)(P.out + OFF_VS + (size_t)m * AW + cs) = v; }
                    else if (seg == 3) *(v2u*)(P.XL + (size_t)R * AW + cs) = o;
                    else {
#pragma unroll
                        for (int jj = 0; jj < 4; ++jj) v[jj] = pg8::gelu_tanh_f(v[jj]);
                        o.x = pg8::cvt_pk_bf16(v[0], v[1]); o.y = pg8::cvt_pk_bf16(v[2], v[3]); *(v2u*)(P.GG + (size_t)R * AW + cs) = o; }
                }
            }
            __syncthreads();
        }
    }
}

constexpr int N_LAUNCHES = MK_N_LAUNCHES, N_PHASES = 9;
__global__ void __launch_bounds__(NWAVES * 64, 2) mega_fwd(Args args) {
    extern __shared__ __attribute__((aligned(16))) unsigned char lds[];
    Frame F;
    F.lds = (LAS unsigned char*)lds;
    F.MISC = (volatile LAS unsigned*)(F.lds + MISC_OFF);
    const int wave0 = __builtin_amdgcn_readfirstlane((int)threadIdx.x >> 6);
    F.wave = wave0; F.lane = (int)__builtin_amdgcn_mbcnt_hi(~0u, __builtin_amdgcn_mbcnt_lo(~0u, 0u)); F.tid = wave0 * 64 + F.lane;
    F.G = gridDim.x;
    unsigned char* ws = args.ws; F.ws = ws; F.out = args.out;
    F.ctl = (gu32*)(ws + WS_CTL);
    for (int u = F.tid; u < (LDS_BYTES - LDSCTL_OFF) / 4; u += NWAVES * 64) ((LAS unsigned*)(F.lds + LDSCTL_OFF))[u] = 0u;
    __syncthreads();
    XcdBarrier bar; bar.bar = (unsigned*)(F.ctl + CW_BAR); bar.x = 0; bar.st = nullptr;
    if (N_LAUNCHES == 1) bar = xcd_barrier_post((unsigned*)(F.ctl + CW_BAR), F.MISC + 8, F.tid == 0);
#define GRID_BAR() do { if (N_LAUNCHES == 1) { REFRESH_F(); xcd_barrier(bar, F.tid == 0); } } while (0)
    const int lo = args.ph_lo, hi = args.ph_hi;
#define REFRESH_F() do { unsigned z_ = 0u; asm volatile("" : "+v"(z_));   const int l_ = (int)__builtin_amdgcn_mbcnt_hi(~0u, __builtin_amdgcn_mbcnt_lo(~0u, z_)); F.lane = l_; F.wave = wave0; F.tid = wave0 * 64 + l_; } while (0)
#define IN(k) (lo <= (k) && (k) < hi)
#define BOTH(k) (IN(k) && IN((k) + 1))
    float* out = args.out;
    pg8::bf16_t* XA = (pg8::bf16_t*)(ws + WS_XA); pg8::bf16_t* Hb = (pg8::bf16_t*)(ws + WS_H); pg8::bf16_t* GRP = (pg8::bf16_t*)(ws + WS_GRP);

    if (IN(0)) { REFRESH_F(); p0_prologue(F, args); if (BOTH(0)) GRID_BAR(); }

    if (IN(1)) {
        REFRESH_F();
        pg8::Gemm g{XA, (const pg8::bf16_t*)(ws + WS_WGU1), MP, NGU, DM, DM, DM}; pg8::StaticOrder S; S.init(MP, NGU, F.G, (int)blockIdx.x);
        pg8::EpiSwiGLU<false> E{Hb, (const float*)(ws + WS_RS1)};
        pg8::gemm_phase<pg8::EpiSwiGLU<false>, pg8::StaticOrder, true, true>(F.lds, g, S, E, F.tid, F.wave);
        { SkP P{}; P.A = XA + (size_t)MP * DM; P.lda = DM; P.B = (const bf16*)(ws + WS_WGU1); P.ldb = DM; P.K = DM; P.ncg = DFF / 16; P.rs = (const float*)(ws + WS_RS1); P.Hout = Hb;
          skinny_phase<SK_SWIGLU>(F, P); }
        if (BOTH(1)) GRID_BAR();
    }
    if (IN(2)) {
        REFRESH_F();
        pg8::Gemm g{Hb, (const pg8::bf16_t*)(ws + WS_WD1), MP, DM, DFF, HLD, DFF}; pg8::StaticOrder S; S.init(MP, DM, F.G, (int)blockIdx.x, true, 4);
        pg8::EpiRes<0, false> E{nullptr, XA, (float*)(ws + WS_SSQ2), nullptr, 0.5f, nullptr};
        pg8::gemm_phase<pg8::EpiRes<0, false>, pg8::StaticOrder, true, true>(F.lds, g, S, E, F.tid, F.wave);
        { SkP P{}; P.A = Hb + (size_t)MP * HLD; P.lda = HLD; P.B = (const bf16*)(ws + WS_WD1); P.ldb = DFF; P.K = DFF; P.ncg = DM / 16;
          P.base = nullptr; P.xa = XA; P.ssq_out = (float*)(ws + WS_SSQ2); P.coef = 0.5f;
          skinny_phase<SK_RES>(F, P); }
        if (BOTH(2)) GRID_BAR();
    }
    if (IN(3)) {
        REFRESH_F();
        pg8::Gemm g{XA, (const pg8::bf16_t*)(ws + WS_WIN), MP, NIN, DM, DM, DM}; pg8::StaticOrder S; S.init(MP, NIN, F.G, (int)blockIdx.x);
        pg8::EpiIn E{(const float*)(ws + WS_SSQ2), (pg8::bf16_t*)(ws + WS_Q), (pg8::bf16_t*)(ws + WS_KB), (pg8::bf16_t*)(ws + WS_VB), (pg8::bf16_t*)(ws + WS_XL), (pg8::bf16_t*)(ws + WS_GG), out};
        pg8::gemm_phase<pg8::EpiIn, pg8::StaticOrder, true, true>(F.lds, g, S, E, F.tid, F.wave);
        { SkP P{}; P.A = XA + (size_t)MP * DM; P.lda = DM; P.B = (const bf16*)(ws + WS_WIN); P.ldb = DM; P.K = DM; P.ncg = NIN / 16; P.ssq_in = (const float*)(ws + WS_SSQ2);
          P.Q = (bf16*)(ws + WS_Q); P.Kb = (bf16*)(ws + WS_KB); P.Vb = (bf16*)(ws + WS_VB); P.GG = (bf16*)(ws + WS_GG); P.XL = (bf16*)(ws + WS_XL); P.out = out;
          skinny_phase<SK_IN>(F, P); }
        if (BOTH(3)) GRID_BAR();
    }
    if (IN(4)) {
        REFRESH_F();
        const int c = (int)blockIdx.x;
        const int nr = F.G - 128;
        if (c >= 128) for (int u = c - 128; u < BS * NH; u += nr) sattn_prefetch(F, args, u >> 3, u & 7);
        for (int k = 0;; ++k) {
            int rowbase, T, n; const float* prefix; const float* h0; float* co; float* ho;
            if (c < 128) { if (k > 0) break; const int b = c >> 3; n = c & 7; rowbase = b * SP; T = SP; prefix = nullptr; h0 = nullptr; co = out + OFF_CP + (size_t)b * 3 * AW; ho = out + OFF_HP + (size_t)b * AW; }
            else { const int u = c - 128 + k * nr; if (u >= BS * 8) break; const int b = u >> 3; n = u & 7; rowbase = MP + TS * b; T = TS; prefix = args.in[4] + (size_t)b * 3 * AW; h0 = args.in[5] + (size_t)b * AW;
                   co = out + OFF_CS + (size_t)b * 3 * AW; ho = out + OFF_HS + (size_t)b * AW; }
            lru_unit(F, args, rowbase, T, n, prefix, h0, co, ho);
        }
        if (c >= 128) for (int u = c - 128; u < BS * NH; u += nr) sattn_unit(F, args, u >> 3, u & 7);
        { if (F.tid == 0) F.MISC[0] = __hip_atomic_fetch_add((unsigned*)(F.ctl + CW_QUEUE), 1u, RLX_AGENT);
          __syncthreads();
          unsigned u = F.MISC[0];
          __syncthreads();
          while (u < (unsigned)(BP * NH * 8)) {
            unsigned nxt = 0u;
            if (F.tid == 0) nxt = __hip_atomic_fetch_add((unsigned*)(F.ctl + CW_QUEUE), 1u, RLX_AGENT);
            const int qb = 7 - (int)(u >> 7), bh = (int)(u & 127);
            attn_unit(F, bh >> 3, bh & 7, qb);
            if (F.tid == 0) F.MISC[0] = nxt;
            __syncthreads();
            u = F.MISC[0];
            __syncthreads();
          } }
        if (BOTH(4)) GRID_BAR();
    }
    if (IN(5)) {
        REFRESH_F();
        pg8::StaticOrder S; S.init(MP, DM, F.G, (int)blockIdx.x, false, 4);
        LAS float* sct = (LAS float*)(F.lds + SCT_OFF);
        { pg8::Unit uu; for (int i = 0; i < 4 && S.next(i, uu); ++i) if (F.tid < 256) { const int row = uu.pm * 256 + F.tid;
              const f32x4 a0 = *(const f32x4*)((const float*)(ws + WS_SSQA) + (size_t)row * 8), a1 = *(const f32x4*)((const float*)(ws + WS_SSQA) + (size_t)row * 8 + 4);
              const f32x4 l0 = *(const f32x4*)((const float*)(ws + WS_SSQL) + (size_t)row * 8), l1 = *(const f32x4*)((const float*)(ws + WS_SSQL) + (size_t)row * 8 + 4);
              const float ta = ((a0[0] + a0[1]) + (a0[2] + a0[3])) + ((a1[0] + a1[1]) + (a1[2] + a1[3])), tl = ((l0[0] + l0[1]) + (l0[2] + l0[3])) + ((l1[0] + l1[1]) + (l1[2] + l1[3]));
              const float sa = 1.0f / sqrtf(ta * (1.0f / AW) + RMS_EPS), sl = 1.0f / sqrtf(tl * (1.0f / AW) + RMS_EPS); sct[(i * 256 + F.tid) * 2 + 0] = sa / sl; sct[(i * 256 + F.tid) * 2 + 1] = sl; }
          __syncthreads(); }
        { pg8::Gemm g{GRP, (const pg8::bf16_t*)(ws + WS_WOUT), MP, DM, DM, DM, DM};
          pg8::EpiRes<2, false> E{nullptr, XA, (float*)(ws + WS_SSQ3), sct, 1.0f, nullptr};
          pg8::gemm_phase<pg8::EpiRes<2, false>, pg8::StaticOrder, true, true, true>(F.lds, g, S, E, F.tid, F.wave); }
        { SkP P{}; P.A = GRP + (size_t)MP * DM; P.lda = DM; P.B = (const bf16*)(ws + WS_WOUT); P.ldb = DM; P.K = DM; P.ncg = DM / 16;
          P.base = nullptr; P.xa = XA; P.ssq_out = (float*)(ws + WS_SSQ3); P.coef = 1.0f;
          skinny_phase<SK_OUT>(F, P, (const float*)(ws + WS_SSQA), (const float*)(ws + WS_SSQL)); }
        if (BOTH(5)) GRID_BAR();
    }
    if (IN(6)) {
        REFRESH_F();
        pg8::Gemm g{XA, (const pg8::bf16_t*)(ws + WS_WGU2), MP, NGU, DM, DM, DM}; pg8::StaticOrder S; S.init(MP, NGU, F.G, (int)blockIdx.x);
        pg8::EpiSwiGLU<true> E{Hb, (const float*)(ws + WS_SSQ3)};
        pg8::gemm_phase<pg8::EpiSwiGLU<true>, pg8::StaticOrder, true, true>(F.lds, g, S, E, F.tid, F.wave);
        { SkP P{}; P.A = XA + (size_t)MP * DM; P.lda = DM; P.B = (const bf16*)(ws + WS_WGU2); P.ldb = DM; P.K = DM; P.ncg = DFF / 16; P.ssq_in = (const float*)(ws + WS_SSQ3); P.Hout = Hb;
          skinny_phase<SK_SWIGLU>(F, P); }
        if (BOTH(6)) GRID_BAR();
    }
    if (IN(7)) {
        REFRESH_F();
        pg8::Gemm g{Hb, (const pg8::bf16_t*)(ws + WS_WD2), MP, DM, DFF, HLD, DFF}; pg8::StaticOrder S; S.init(MP, DM, F.G, (int)blockIdx.x, true, 4);
        pg8::EpiRes<0, false> E{nullptr, XA, (float*)(ws + WS_SSQ4), nullptr, 0.5f, nullptr};
        pg8::gemm_phase<pg8::EpiRes<0, false>, pg8::StaticOrder, true, true>(F.lds, g, S, E, F.tid, F.wave);
        { SkP P{}; P.A = Hb + (size_t)MP * HLD; P.lda = HLD; P.B = (const bf16*)(ws + WS_WD2); P.ldb = DFF; P.K = DFF; P.ncg = DM / 16;
          P.base = nullptr; P.xa = XA; P.ssq_out = (float*)(ws + WS_SSQ4); P.coef = 0.5f;
          skinny_phase<SK_RES>(F, P); }
        if (BOTH(7)) GRID_BAR();
    }
    if (IN(8)) {
        REFRESH_F();
        const int gw = blockIdx.x * NWAVES + F.wave, NGW = F.G * NWAVES;
        f32x4 gfv[8];
        { const GAS f32x4* gf = (const GAS f32x4*)args.in[27] + 2 * F.lane;
#pragma unroll
          for (int j = 0; j < 4; ++j) { gfv[2 * j] = gf[128 * j]; gfv[2 * j + 1] = gf[128 * j + 1]; } }
        const float* ssq4 = (const float*)(ws + WS_SSQ4);
        for (int m0 = gw; m0 < MP + MS; m0 += 2 * NGW) {
            v4u v[2][4]; float rsv[2];
#pragma unroll
            for (int q = 0; q < 2; ++q) { const int m = m0 + q * NGW; if (m < MP + MS) {
                const GAS v4u* xr = (const GAS v4u*)(XA + (size_t)m * DM) + F.lane;
#pragma unroll
                for (int j = 0; j < 4; ++j) v[q][j] = xr[64 * j];
                rsv[q] = ssq4[m]; } }
#pragma unroll
            for (int q = 0; q < 2; ++q) { const int m = m0 + q * NGW; if (m < MP + MS) {
                float* rowp = m < MP ? out + OFF_YP + (size_t)m * DM : out + OFF_YS + (size_t)(m - MP) * DM;
                GAS f32x4* xw = (GAS f32x4*)rowp + 2 * F.lane;
                const float rs = 1.0f / sqrtf(rsv[q] * (1.0f / DM) + RMS_EPS);
#pragma unroll
                for (int j = 0; j < 4; ++j) { const v4u w = v[q][j];
                    const f32x4 a = {__builtin_bit_cast(float, w.x << 16), __builtin_bit_cast(float, w.x & 0xffff0000u), __builtin_bit_cast(float, w.y << 16), __builtin_bit_cast(float, w.y & 0xffff0000u)};
                    const f32x4 b = {__builtin_bit_cast(float, w.z << 16), __builtin_bit_cast(float, w.z & 0xffff0000u), __builtin_bit_cast(float, w.w << 16), __builtin_bit_cast(float, w.w & 0xffff0000u)};
                    xw[128 * j] = a * rs * gfv[2 * j]; xw[128 * j + 1] = b * rs * gfv[2 * j + 1]; } } }
        }
    }
#undef IN
#undef BOTH
#undef GRID_BAR
}

extern "C" void kernel_launch(void* const* d_in, const int* in_sizes, int n_in, void* d_out, int out_size, void* d_ws, size_t ws_size, hipStream_t stream) {
    static int grid = 0;
    if (grid == 0) {
        if (n_in != 28 || in_sizes[0] != MP * DM || (size_t)out_size != OUT_TOTAL || ws_size < WS_END) {
            fprintf(stderr, "kernel_launch: unexpected shapes (n_in %d, in0 %d, out %d, ws %zu); nothing launched\n", n_in, n_in > 0 ? in_sizes[0] : -1, out_size, ws_size); grid = -1; return; }
        int dev = 0, cus = 0, per_cu = 0;
        if (hipGetDevice(&dev) != hipSuccess || hipDeviceGetAttribute(&cus, hipDeviceAttributeMultiprocessorCount, dev) != hipSuccess) { grid = -1; return; }
        if (hipFuncSetAttribute((const void*)mega_fwd, hipFuncAttributeMaxDynamicSharedMemorySize, LDS_BYTES) != hipSuccess) { fprintf(stderr, "kernel_launch: hipFuncSetAttribute failed\n"); grid = -1; return; }
        if (hipOccupancyMaxActiveBlocksPerMultiprocessor(&per_cu, (const void*)mega_fwd, NWAVES * 64, LDS_BYTES) != hipSuccess || per_cu < 1)
            fprintf(stderr, "kernel_launch: occupancy query reports %d workgroups per CU\n", per_cu);
        (void)hipGetLastError();
        grid = cus;
        if (grid < 129) { fprintf(stderr, "kernel_launch: needs >= 129 CUs\n"); grid = -1; return; }
    }
    if (grid < 0) return;
    (void)hipMemsetAsync((char*)d_ws + WS_CTL, 0, CTL_ZERO_BYTES, stream);
    Args a{};
    for (int i = 0; i < 28; ++i) a.in[i] = (const float*)d_in[i];
    a.out = (float*)d_out; a.ws = (unsigned char*)d_ws;
    if (N_LAUNCHES == 1) { a.ph_lo = 0; a.ph_hi = N_PHASES; hipLaunchKernelGGL(mega_fwd, dim3(grid), dim3(NWAVES * 64), LDS_BYTES, stream, a); }
    else for (int li = 0; li < N_PHASES; ++li) { a.ph_lo = li; a.ph_hi = li + 1; hipLaunchKernelGGL(mega_fwd, dim3(grid), dim3(NWAVES * 64), LDS_BYTES, stream, a); }
}
```

```cpp
#include <hip/hip_runtime.h>
#include <cstdio>
#include <cstdint>

#ifndef MK_N_LAUNCHES
#define MK_N_LAUNCHES 1
#endif

#define LAS __attribute__((address_space(3)))
#define GAS __attribute__((address_space(1)))

constexpr int DM = 2048, BP = 16, SP = 2048, MP = BP * SP  , BS = 32, TS = 4, MS = BS * TS  ;
constexpr int MPAD = MP + 256  , NMT = MPAD / 256  ;
constexpr int DFF = 5632, HLD = DFF + 64  , NGU = 2 * DFF, NIN = 5120, AW = 1024, NH = 8, HD = 128;
constexpr float RMS_EPS = 1e-6f;
constexpr float LOG2E = 1.4426950408889634f;
constexpr float ATT_C2 = 0.08838834764831845f * 1.4426950408889634f;
constexpr int TBN = 2432;

constexpr size_t OFF_YP = 0, OFF_YS = 67108864, OFF_KP = 67371008, OFF_VP = 100925440, OFF_CP = 134479872, OFF_HP = 134529024,
                 OFF_KS = 134545408, OFF_VS = 134676480, OFF_CS = 134807552, OFF_HS = 134905856, OUT_TOTAL = 134938624;

constexpr size_t MiB = 1u << 20;
constexpr size_t WS_CTL = 0, CTL_ZERO_BYTES = 64 * 1024;
constexpr size_t WS_RS1 = 1 * MiB, WS_SSQ2 = WS_RS1 + 256 * 1024, WS_SSQ3 = WS_RS1 + 512 * 1024, WS_SSQ4 = WS_RS1 + 768 * 1024;
constexpr size_t WS_TBL = 2 * MiB, WS_WAX = 3 * MiB, WS_SSQA = 4 * MiB, WS_SSQL = 6 * MiB;
constexpr size_t WS_WGU1 = 8 * MiB, WS_WD1 = 52 * MiB, WS_WIN = 74 * MiB, WS_WOUT = 94 * MiB, WS_WGU2 = 102 * MiB, WS_WD2 = 146 * MiB;
constexpr size_t WS_XA = 168 * MiB, WS_GRP = 297 * MiB, WS_GG = 426 * MiB, WS_H = 491 * MiB;
constexpr size_t WS_Q = WS_H, WS_KB = WS_H + 65 * MiB, WS_VB = WS_H + 130 * MiB, WS_XL = WS_H + 195 * MiB;
constexpr size_t WS_END = 852 * MiB;
static_assert((size_t)MPAD * DM * 2 <= 129 * MiB && (size_t)MPAD * HLD * 2 <= 361 * MiB && (size_t)MPAD * AW * 2 <= 65 * MiB && (size_t)MPAD * AW * 4 <= 129 * MiB, "ws map");
static_assert(WS_XL + (size_t)MPAD * AW * 4 <= WS_END && (size_t)MPAD * 8 * 4 <= 2 * MiB && (size_t)MPAD * 4 <= 256 * 1024, "ws map 2");
constexpr int CW_TMO = 0, CW_CODE = 1, CW_QUEUE = 64, CW_BAR = 4096;

constexpr int RING_BYTES = 131072, LDSCTL_OFF = RING_BYTES, MISC_OFF = LDSCTL_OFF + 320, LDS_BYTES = 147456;
constexpr int RV_OFF = LDSCTL_OFF + 512  , SCT_OFF = RV_OFF + 2048  ;
static_assert(SCT_OFF + 4 * 256 * 2 * 4 <= LDS_BYTES, "lds map");


template <int CTRL> __device__ __forceinline__ float dppf(float v) { return __builtin_bit_cast(float, __builtin_amdgcn_update_dpp(0, __builtin_bit_cast(int, v), CTRL, 0xF, 0xF, true)); }
__device__ __forceinline__ float sum_x1(float v) { return v + dppf<0xB1>(v); }
__device__ __forceinline__ float sum_x2(float v) { return v + dppf<0x4E>(v); }
__device__ __forceinline__ float sum16(float v) { v = sum_x1(v); v = sum_x2(v); v += dppf<0x141>(v); v += dppf<0x140>(v); return v; }
__device__ __forceinline__ float sum_r16(float v) { auto r = __builtin_amdgcn_permlane16_swap(__builtin_bit_cast(unsigned, v), __builtin_bit_cast(unsigned, v), false, false);
    return __builtin_bit_cast(float, (unsigned)r[0]) + __builtin_bit_cast(float, (unsigned)r[1]); }
__device__ __forceinline__ float sum_r32(float v) { auto r = __builtin_amdgcn_permlane32_swap(__builtin_bit_cast(unsigned, v), __builtin_bit_cast(unsigned, v), false, false);
    return __builtin_bit_cast(float, (unsigned)r[0]) + __builtin_bit_cast(float, (unsigned)r[1]); }

namespace pg8 {
#define PG8_LAS __attribute__((address_space(3)))
typedef unsigned short bf16_t;
typedef short bf16x8 __attribute__((ext_vector_type(8)));
typedef float f32x4 __attribute__((ext_vector_type(4)));
typedef unsigned u32x4 __attribute__((ext_vector_type(4)));
typedef unsigned u32x2 __attribute__((ext_vector_type(2)));
constexpr int BM = 256, BK = 64, HALF = 128, HTB = HALF * BK * 2, STAGE_BYTES = 8 * HTB, NXCD = 8, WGM = 8;

__host__ __device__ __forceinline__ int lds_byte(int r, int c) { const int st = (r >> 4) * 2 + (c >> 5), rr = r & 15, cc = c & 31, ob = rr * 64 + cc * 2; return st * 1024 + (ob ^ (((ob >> 9) & 1) << 5)); }
__host__ __device__ __forceinline__ void stage_rc(int b, int& R, int& C) { const int st = b / 1024, sb = b % 1024, swz = sb ^ (((sb >> 9) & 1) << 5); R = (st >> 1) * 16 + swz / 64; C = (st & 1) * 32 + (swz % 64) / 2; }
__host__ __device__ __forceinline__ int perm32(int rho) { const int n = rho >> 4, i = rho & 15; return 8 * (i >> 2) + 4 * n + (i & 3); }

struct Unit { int pm, pn; };
struct Gemm { const bf16_t* A; const bf16_t* Bt; int M, N, K, lda, ldb; };

struct StaticOrder {
    int nM, nN, nwg, G, c, R, wgm;
    __host__ __device__ __forceinline__ void init(int M, int N, int G_, int c_, bool rev = false, int wgm_ = WGM) { nM = M / BM; nN = N / BM; nwg = nM * nN; G = G_; c = c_; R = rev ? (nwg + G_ - 1) / G_ : 0; wgm = wgm_; }
    __host__ __device__ __forceinline__ bool next(int i, Unit& u) const {
        if (R > 0 && i >= R) return false;
        const long L = (long)(R > 0 ? R - 1 - i : i) * G + c; if (L >= nwg) return false;
        int wgid = (int)L; { const int q = nwg / NXCD, r = nwg % NXCD, xcd = wgid % NXCD, off = wgid / NXCD; wgid = (xcd < r ? xcd * (q + 1) : r * (q + 1) + (xcd - r) * q) + off; }
        const int nig = wgm * nN, gid = wgid / nig, fm = gid * wgm, gsz = (nM - fm) < wgm ? (nM - fm) : wgm;
        u.pm = fm + ((wgid % nig) % gsz); u.pn = (wgid % nig) / gsz; return true;
    }
    __device__ __forceinline__ void a_ready(const Unit&) const {}
    __device__ __forceinline__ void done(const Unit&) const {}
};

__device__ __forceinline__ unsigned cvt_pk_bf16(float lo, float hi) { unsigned r; asm volatile("v_cvt_pk_bf16_f32 %0, %1, %2" : "=v"(r) : "v"(lo), "v"(hi)); return r; }
__device__ __forceinline__ u32x4 pack8(const f32x4 a, const f32x4 b) { u32x4 w; w.x = cvt_pk_bf16(a[0], a[1]); w.y = cvt_pk_bf16(a[2], a[3]); w.z = cvt_pk_bf16(b[0], b[1]); w.w = cvt_pk_bf16(b[2], b[3]); return w; }
__device__ __forceinline__ float fast_rcp(float x) { return __builtin_amdgcn_rcpf(x); }
__device__ __forceinline__ float fast_exp2(float x) { return __builtin_amdgcn_exp2f(x); }
__device__ __forceinline__ float silu_f(float x) { return x * fast_rcp(1.0f + fast_exp2(-x * 1.4426950408889634f)); }
__device__ __forceinline__ float sigmoid_f(float x) { return fast_rcp(1.0f + fast_exp2(-x * 1.4426950408889634f)); }
__device__ __forceinline__ float gelu_tanh_f(float x) { const float z = 0.7978845608028654f * (x + 0.044715f * x * x * x); return x * fast_rcp(1.0f + fast_exp2(-2.0f * 1.4426950408889634f * z)); }


template <bool FROM_SSQ> struct EpiSwiGLU {
    static constexpr bool PERM = true, AFTER_DRAIN = false; static constexpr int ROWVEC = 1;
    bf16_t* Hout; const float* rowvec;
    __device__ __forceinline__ void operator()(const f32x4 (&acc)[2][2][4][2], const Unit& u, int ui, const PG8_LAS float* rv, int wr, int wc, int fr_in, int fq_in) const {
        int fr = fr_in, fq = fq_in; asm volatile("" : "+v"(fr), "+v"(fq));
        const int rl0 = wr * 64 + fr, row0 = u.pm * BM + rl0, colh = u.pn * 128 + wc * 32 + 8 * fq;
#pragma unroll
        for (int ai = 0; ai < 2; ++ai) {
#pragma unroll
            for (int m = 0; m < 4; ++m) {
                const int row = row0 + ai * HALF + m * 16;
                const float rvv = rv[rl0 + ai * HALF + m * 16];
                const float s = FROM_SSQ ? 1.0f / sqrtf(rvv * (1.0f / DM) + RMS_EPS) : rvv;
                f32x4 h0, h1;
#pragma unroll
                for (int j = 0; j < 4; ++j) { h0[j] = silu_f(acc[ai][0][m][0][j] * s) * (acc[ai][1][m][0][j] * s); h1[j] = silu_f(acc[ai][0][m][1][j] * s) * (acc[ai][1][m][1][j] * s); }
                *(u32x4*)(Hout + (size_t)row * HLD + colh) = pack8(h0, h1);
            }
        }
    }
};

template <int SC, bool BASE_F32>
struct EpiRes {
    static constexpr bool PERM = true, AFTER_DRAIN = false; static constexpr int ROWVEC = 0;
    const float* baseP; bf16_t* xa; float* ssq; const PG8_LAS float* sct; float coef; const float* rowvec;
    __device__ __forceinline__ void midk(f32x4 (&acc)[2][2][4][2], int ui, int wr, int fr_in) const {
        int fr = fr_in; asm volatile("" : "+v"(fr));
#pragma unroll
        for (int ai = 0; ai < 2; ++ai)
#pragma unroll
            for (int m = 0; m < 4; ++m) { const float r = sct[(ui * 256 + wr * 64 + fr + ai * HALF + m * 16) * 2];
#pragma unroll
                for (int bj = 0; bj < 2; ++bj)
#pragma unroll
                    for (int n = 0; n < 2; ++n) acc[ai][bj][m][n] = acc[ai][bj][m][n] * r; }
    }
    __device__ __forceinline__ void operator()(const f32x4 (&acc)[2][2][4][2], const Unit& u, int ui, const PG8_LAS float* rv, int wr, int wc, int fr_in, int fq_in) const {
        int fr = fr_in, fq = fq_in; asm volatile("" : "+v"(fr), "+v"(fq));
        const int rl0 = wr * 64 + fr, row0 = u.pm * BM + rl0, col0 = u.pn * BM + wc * 32 + 8 * fq;
#pragma unroll
        for (int ai = 0; ai < 2; ++ai) {
            f32x4 bb[4][2][2];
#pragma unroll
            for (int m = 0; m < 4; ++m)
#pragma unroll
                for (int bj = 0; bj < 2; ++bj) { const size_t off = (size_t)(row0 + ai * HALF + m * 16) * DM + col0 + bj * HALF;
                    if (BASE_F32) { bb[m][bj][0] = *(const f32x4*)(baseP + off); bb[m][bj][1] = *(const f32x4*)(baseP + off + 4); }
                    else { const u32x4 w = *(const u32x4*)(xa + off);
                        bb[m][bj][0] = (f32x4){__builtin_bit_cast(float, w.x << 16), __builtin_bit_cast(float, w.x & 0xffff0000u), __builtin_bit_cast(float, w.y << 16), __builtin_bit_cast(float, w.y & 0xffff0000u)};
                        bb[m][bj][1] = (f32x4){__builtin_bit_cast(float, w.z << 16), __builtin_bit_cast(float, w.z & 0xffff0000u), __builtin_bit_cast(float, w.w << 16), __builtin_bit_cast(float, w.w & 0xffff0000u)}; } }
            asm volatile("" ::: "memory");
#pragma unroll
            for (int m = 0; m < 4; ++m) {
                const int row = row0 + ai * HALF + m * 16;
                float sc = coef;
                if (SC) sc = coef * sct[(ui * 256 + rl0 + ai * HALF + m * 16) * 2 + (SC - 1)];
                float ss = 0.f;
#pragma unroll
                for (int bj = 0; bj < 2; ++bj) {
                    const int c = col0 + bj * HALF;
                    const f32x4 x0 = bb[m][bj][0] + acc[ai][bj][m][0] * sc, x1 = bb[m][bj][1] + acc[ai][bj][m][1] * sc;
                    *(u32x4*)(xa + (size_t)row * DM + c) = pack8(x0, x1);
                    ss += ((x0[0] * x0[0] + x0[1] * x0[1]) + (x0[2] * x0[2] + x0[3] * x0[3])) + ((x1[0] * x1[0] + x1[1] * x1[1]) + (x1[2] * x1[2] + x1[3] * x1[3]));
                }
                ss = sum_r16(ss); ss = sum_r32(ss);
                if (fq == 0) __hip_atomic_fetch_add(ssq + row, ss, __ATOMIC_RELAXED, __HIP_MEMORY_SCOPE_AGENT);
            }
            asm volatile("" ::: "memory");
        }
    }
};

struct EpiIn {
    static constexpr bool PERM = true, AFTER_DRAIN = false; static constexpr int ROWVEC = 1;
    const float* rowvec; bf16_t* Q; bf16_t* Kb; bf16_t* Vb; bf16_t* XL; bf16_t* GG; float* out;
    __device__ __forceinline__ void operator()(const f32x4 (&acc)[2][2][4][2], const Unit& u, int ui, const PG8_LAS float* rv, int wr, int wc, int fr_in, int fq_in) const {
        int fr = fr_in, fq = fq_in; asm volatile("" : "+v"(fr), "+v"(fq));
        const int rl0 = wr * 64 + fr, row0 = u.pm * BM + rl0, seg = u.pn >> 2, cs0 = (u.pn & 3) * BM + wc * 32 + 8 * fq;
#pragma unroll
        for (int ai = 0; ai < 2; ++ai) {
#pragma unroll
            for (int m = 0; m < 4; ++m) {
                const int row = row0 + ai * HALF + m * 16;
                const float s = 1.0f / sqrtf(rv[rl0 + ai * HALF + m * 16] * (1.0f / DM) + RMS_EPS);
#pragma unroll
                for (int bj = 0; bj < 2; ++bj) {
                    const int cs = cs0 + bj * HALF;
                    f32x4 v0 = acc[ai][bj][m][0] * s, v1 = acc[ai][bj][m][1] * s;
                    if (seg == 0) { *(u32x4*)(Q + (size_t)row * AW + cs) = pack8(v0 * ATT_C2, v1 * ATT_C2); }
                    else if (seg == 1 || seg == 2) {
                        bf16_t* bb = seg == 1 ? Kb : Vb; *(u32x4*)(bb + (size_t)row * AW + cs) = pack8(v0, v1);
                        float* o = out + (seg == 1 ? OFF_KP : OFF_VP) + (size_t)row * AW + cs;
                        *(f32x4*)o = v0; *(f32x4*)(o + 4) = v1; }
                    else if (seg == 3) { *(u32x4*)(XL + (size_t)row * AW + cs) = pack8(v0, v1); }
                    else {
#pragma unroll
                        for (int j = 0; j < 4; ++j) { v0[j] = gelu_tanh_f(v0[j]); v1[j] = gelu_tanh_f(v1[j]); }
                        *(u32x4*)(GG + (size_t)row * AW + cs) = pack8(v0, v1); }
                }
            }
        }
    }
};

template <class Epi, class Sched, bool ALIGN_EPI = false, bool SP2 = false, bool MIDK = false>
__device__ __forceinline__ void gemm_phase(PG8_LAS unsigned char* lds, const Gemm g, const Sched& S, const Epi& E, const int tid, const int wid) {
    const int lane = tid & 63, wr = wid >> 2, wc = wid & 3, fr = lane & 15, fq = lane >> 4;
    const int K = g.K, nt = K / BK;
    unsigned voffA[2], voffB[2];
#pragma unroll
    for (int i = 0; i < 2; ++i) { int R, C; stage_rc(tid * 16 + i * 8192, R, C); const int Rb = Epi::PERM ? ((R & ~31) + perm32(R & 31)) : R;
        voffA[i] = (unsigned)(R * g.lda + C) * 2u; voffB[i] = (unsigned)(Rb * g.ldb + C) * 2u; }
    const size_t kstep = (size_t)(BK * 2);
    const size_t hstepA = (size_t)HALF * g.lda * 2, hstepB = (size_t)HALF * g.ldb * 2;
    const size_t tstepA = 2 * hstepA, tstepB = 2 * hstepB;
    const unsigned ldsw = (unsigned)wid * 1024u;
    const int aoff = lds_byte(wr * 64 + fr, fq * 8), boff = lds_byte(wc * 32 + fr, fq * 8);
#define PG8_SA(b, h) (((b) * 2 + (h)) * HTB)
#define PG8_SB(b, h) ((4 + (b) * 2 + (h)) * HTB)
#define PG8_STAGE(bufoff, gbase, voff) do { _Pragma("unroll") for (int _i = 0; _i < 2; ++_i) \
        __builtin_amdgcn_global_load_lds((const unsigned*)((const char*)(gbase) + (voff)[_i]), (PG8_LAS unsigned*)(lds + (bufoff) + ldsw + _i * 8192), 16, 0, 0); } while (0)
#define PG8_LDA(dst, b, h) do { _Pragma("unroll") for (int m = 0; m < 4; ++m) _Pragma("unroll") for (int k = 0; k < 2; ++k) dst[m][k] = *(const PG8_LAS bf16x8*)(lds + PG8_SA(b, h) + aoff + m * 2048 + k * 1024); } while (0)
#define PG8_LDB(dst, b, h) do { _Pragma("unroll") for (int n = 0; n < 2; ++n) _Pragma("unroll") for (int k = 0; k < 2; ++k) dst[n][k] = *(const PG8_LAS bf16x8*)(lds + PG8_SB(b, h) + boff + n * 2048 + k * 1024); } while (0)
#define PG8_MMA(ai, bj, At, Bt) do { __builtin_amdgcn_s_setprio(1); _Pragma("unroll") for (int m = 0; m < 4; ++m) _Pragma("unroll") for (int n = 0; n < 2; ++n) _Pragma("unroll") for (int k = 0; k < 2; ++k) \
        acc[ai][bj][m][n] = __builtin_amdgcn_mfma_f32_16x16x32_bf16(Bt[n][k], At[m][k], acc[ai][bj][m][n], 0, 0, 0); __builtin_amdgcn_s_setprio(0); } while (0)
#define PG8_WAIT_V(n) asm volatile("s_waitcnt vmcnt(" #n ")" ::: "memory")
#define PG8_WAIT_L(n) asm volatile("s_waitcnt lgkmcnt(" #n ")" ::: "memory")
#define PG8_BAR __builtin_amdgcn_s_barrier()
#define PG8_SCHED __builtin_amdgcn_sched_barrier(0)
    Unit cur, nxt; int ui = 0;
    if (!S.next(0, cur)) return;
    f32x4 acc[2][2][4][2];
#pragma unroll
    for (int a = 0; a < 2; ++a)
#pragma unroll
        for (int b = 0; b < 2; ++b)
#pragma unroll
            for (int m = 0; m < 4; ++m)
#pragma unroll
                for (int n = 0; n < 2; ++n) acc[a][b][m][n] = (f32x4){0.f, 0.f, 0.f, 0.f};
    bf16x8 At[4][2], B0[2][2], B1[2][2];
    const char* cA = (const char*)g.A + (size_t)cur.pm * tstepA; const char* cB = (const char*)g.Bt + (size_t)cur.pn * tstepB;
    S.a_ready(cur);
    if constexpr (SP2) {
        PG8_STAGE(PG8_SB(0, 0), cB, voffB); PG8_STAGE(PG8_SB(0, 1), cB + hstepB, voffB); PG8_STAGE(PG8_SA(0, 0), cA, voffA); PG8_STAGE(PG8_SA(0, 1), cA + hstepA, voffA);
        if (wr == 1) PG8_BAR;
        PG8_WAIT_V(2); PG8_BAR;
        PG8_STAGE(PG8_SB(1, 0), cB + kstep, voffB); PG8_STAGE(PG8_SA(1, 0), cA + kstep, voffA); PG8_STAGE(PG8_SB(1, 1), cB + hstepB + kstep, voffB);
        PG8_WAIT_V(6); PG8_BAR;
    } else {
        PG8_STAGE(PG8_SB(0, 0), cB, voffB); PG8_STAGE(PG8_SA(0, 0), cA, voffA); PG8_STAGE(PG8_SB(0, 1), cB + hstepB, voffB); PG8_STAGE(PG8_SA(0, 1), cA + hstepA, voffA);
        if (wr == 1) PG8_BAR;
        PG8_WAIT_V(4); PG8_BAR;
        PG8_STAGE(PG8_SB(1, 0), cB + kstep, voffB); PG8_STAGE(PG8_SA(1, 0), cA + kstep, voffA); PG8_STAGE(PG8_SB(1, 1), cB + hstepB + kstep, voffB);
        PG8_WAIT_V(6); PG8_BAR;
    }
    for (;;) {
        const bool has_next = S.next(ui + 1, nxt);
        const char* nA = has_next ? (const char*)g.A + (size_t)nxt.pm * tstepA : cA; const char* nB = has_next ? (const char*)g.Bt + (size_t)nxt.pn * tstepB : cB;
        if constexpr (Epi::ROWVEC != 0) { if (wid < 4) {
            int ln = fr | (fq << 4); asm volatile("" : "+v"(ln));
            __builtin_amdgcn_global_load_lds((const unsigned*)(E.rowvec + (size_t)cur.pm * BM + wid * 64 + ln), (PG8_LAS unsigned*)(lds + RV_OFF + (ui & 1) * 1024 + wid * 256), 4, 0, 0); } }
        for (int hseg = 0; hseg < (MIDK ? 2 : 1); ++hseg) {
        const int tbeg = MIDK ? hseg * (nt / 2) : 0, tend = MIDK ? tbeg + nt / 2 : nt;
        for (int t = tbeg; t < tend; t += 2) {
            const bool last = (t == nt - 2);
            const char* a1 = cA + (size_t)(t + 1) * kstep;
            const char* a2 = last ? nA : cA + (size_t)(t + 2) * kstep; const char* b2 = last ? nB : cB + (size_t)(t + 2) * kstep;
            const char* a3 = a2 + kstep; const char* b3 = b2 + kstep;
            if (last && has_next) S.a_ready(nxt);
            if constexpr (SP2) {
            PG8_LDB(B0, 0, 0); PG8_LDB(B1, 0, 1); PG8_SCHED; PG8_LDA(At, 0, 0); PG8_STAGE(PG8_SA(1, 1), a1 + hstepA, voffA);
            PG8_WAIT_V(8); PG8_WAIT_L(0); PG8_BAR; PG8_MMA(0, 0, At, B0); PG8_MMA(0, 1, At, B1); PG8_BAR; PG8_SCHED;
            PG8_LDA(At, 0, 1); PG8_STAGE(PG8_SB(0, 0), b2, voffB); PG8_STAGE(PG8_SB(0, 1), b2 + hstepB, voffB); PG8_STAGE(PG8_SA(0, 0), a2, voffA);
            PG8_WAIT_V(8); PG8_WAIT_L(0); PG8_BAR; PG8_MMA(1, 0, At, B0); PG8_MMA(1, 1, At, B1); PG8_BAR; PG8_SCHED;
            PG8_LDB(B0, 1, 0); PG8_LDB(B1, 1, 1); PG8_SCHED; PG8_LDA(At, 1, 0); PG8_STAGE(PG8_SA(0, 1), a2 + hstepA, voffA);
            PG8_WAIT_V(8); PG8_WAIT_L(0); PG8_BAR; PG8_MMA(0, 0, At, B0); PG8_MMA(0, 1, At, B1); PG8_BAR; PG8_SCHED;
            PG8_LDA(At, 1, 1); PG8_STAGE(PG8_SB(1, 0), b3, voffB); PG8_STAGE(PG8_SB(1, 1), b3 + hstepB, voffB); PG8_STAGE(PG8_SA(1, 0), a3, voffA);
            PG8_WAIT_V(8); PG8_WAIT_L(0); PG8_BAR; PG8_MMA(1, 0, At, B0); PG8_MMA(1, 1, At, B1); PG8_BAR; PG8_SCHED;
            } else {
            PG8_LDB(B0, 0, 0); PG8_SCHED; PG8_LDA(At, 0, 0); PG8_STAGE(PG8_SA(1, 1), a1 + hstepA, voffA);
            PG8_WAIT_L(8); PG8_BAR; PG8_WAIT_L(0); PG8_MMA(0, 0, At, B0); PG8_BAR; PG8_SCHED;
            PG8_LDB(B1, 0, 1); PG8_STAGE(PG8_SB(0, 0), b2, voffB);
            PG8_BAR; PG8_WAIT_L(0); PG8_MMA(0, 1, At, B1); PG8_BAR;
            PG8_LDA(At, 0, 1); PG8_STAGE(PG8_SA(0, 0), a2, voffA);
            PG8_BAR; PG8_WAIT_L(0); PG8_MMA(1, 0, At, B0); PG8_BAR; PG8_SCHED;
            PG8_STAGE(PG8_SB(0, 1), b2 + hstepB, voffB);
            PG8_WAIT_V(6); PG8_BAR; PG8_MMA(1, 1, At, B1); PG8_BAR;
            PG8_LDB(B0, 1, 0); PG8_SCHED; PG8_LDA(At, 1, 0); PG8_STAGE(PG8_SA(0, 1), a2 + hstepA, voffA);
            PG8_WAIT_L(8); PG8_BAR; PG8_WAIT_L(0); PG8_MMA(0, 0, At, B0); PG8_BAR; PG8_SCHED;
            PG8_LDB(B1, 1, 1); PG8_STAGE(PG8_SB(1, 0), b3, voffB);
            PG8_BAR; PG8_WAIT_L(0); PG8_MMA(0, 1, At, B1); PG8_BAR;
            PG8_LDA(At, 1, 1); PG8_STAGE(PG8_SA(1, 0), a3, voffA);
            PG8_BAR; PG8_WAIT_L(0); PG8_MMA(1, 0, At, B0); PG8_BAR; PG8_SCHED;
            PG8_STAGE(PG8_SB(1, 1), b3 + hstepB, voffB);
            PG8_WAIT_V(6); PG8_BAR; PG8_MMA(1, 1, At, B1); PG8_BAR;
            }
        }
        if constexpr (MIDK) { if (hseg == 0) E.midk(acc, ui, wr, fr); }
        }
        if constexpr (ALIGN_EPI) { if (wr == 0) PG8_BAR; }
        E(acc, cur, ui, (const PG8_LAS float*)(lds + RV_OFF + (ui & 1) * 1024), wr, wc, fr, fq); S.done(cur);
        if (!has_next) break;
#pragma unroll
        for (int a = 0; a < 2; ++a)
#pragma unroll
            for (int b = 0; b < 2; ++b)
#pragma unroll
                for (int m = 0; m < 4; ++m)
#pragma unroll
                    for (int n = 0; n < 2; ++n) acc[a][b][m][n] = (f32x4){0.f, 0.f, 0.f, 0.f};
        cur = nxt; cA = nA; cB = nB; ++ui;
        if constexpr (ALIGN_EPI) { if (wr == 1) PG8_BAR; }
    }
    PG8_WAIT_V(0);
    if constexpr (!ALIGN_EPI) { if (wr == 0) PG8_BAR; }
    PG8_BAR;
#undef PG8_SA
#undef PG8_SB
#undef PG8_STAGE
#undef PG8_LDA
#undef PG8_LDB
#undef PG8_MMA
#undef PG8_WAIT_V
#undef PG8_WAIT_L
#undef PG8_BAR
#undef PG8_SCHED
}
}

typedef unsigned short bf16;
typedef unsigned v4u __attribute__((ext_vector_type(4)));
typedef unsigned v2u __attribute__((ext_vector_type(2)));
typedef float f32x4 __attribute__((ext_vector_type(4)));
typedef float f32x16 __attribute__((ext_vector_type(16)));
typedef short bf16x8 __attribute__((ext_vector_type(8)));
typedef short s16x4 __attribute__((ext_vector_type(4)));
typedef GAS unsigned gu32;
#define RLX_AGENT __ATOMIC_RELAXED, __HIP_MEMORY_SCOPE_AGENT
#define LDS_WAIT() asm volatile("s_waitcnt lgkmcnt(0)" ::: "memory")
#define VM_WAIT() asm volatile("s_waitcnt vmcnt(0)" ::: "memory")
__device__ __forceinline__ unsigned f2bf(float f) { unsigned u = __builtin_bit_cast(unsigned, f); return (u + 0x7fffu + ((u >> 16) & 1u)) >> 16; }
__device__ __forceinline__ unsigned pk2(float lo, float hi) { return f2bf(lo) | (f2bf(hi) << 16); }
__device__ __forceinline__ float bf2f(unsigned short b) { return __builtin_bit_cast(float, ((unsigned)b) << 16); }

#define XB_TMO      128
#define XB_XCNT(j)  (256  + 64 * (j))
#define XB_XSUB(j)  (1280 + 64 * (j))
#define XB_XGEN(j)  (2304 + 64 * (j))
#define XB_TOP      3328
#define XB_TOPGEN   3392
#define XCD_BAR_WORDS 3456
#define XB_SPIN_CAP (1u << 18)
__device__ __forceinline__ unsigned xb_ld(unsigned* p)              { return __hip_atomic_load(p, __ATOMIC_RELAXED, __HIP_MEMORY_SCOPE_AGENT); }
__device__ __forceinline__ unsigned xb_add(unsigned* p, unsigned v) { return __hip_atomic_fetch_add(p, v, __ATOMIC_RELAXED, __HIP_MEMORY_SCOPE_AGENT); }
__device__ __forceinline__ unsigned xb_xcc_id() { return (unsigned)__builtin_amdgcn_s_getreg((3 << 11) | 20) & 0xFu; }
#define XB_SPIN(cond, bar) do { unsigned _sp = 0; while (cond) { __builtin_amdgcn_s_sleep(1); \
    if ((++_sp & 255u) == 0u) { if (xb_ld(&(bar)[XB_TMO])) break; if (_sp > XB_SPIN_CAP) { atomicAdd(&(bar)[XB_TMO], 1u); break; } } } } while (0)
struct XcdBarrier { unsigned* bar; unsigned x; volatile LAS unsigned* st; };
__device__ __forceinline__ XcdBarrier xcd_barrier_post(unsigned* bar, volatile LAS unsigned* st, const bool leader  ) {
    XcdBarrier b; b.bar = bar; b.x = xb_xcc_id(); b.st = st;
    if (leader) (void)xb_add(&bar[XB_XCNT(b.x)], 1u);
    return b;
}
__device__ __forceinline__ void xcd_barrier_complete(unsigned* bar, unsigned x, unsigned& nloc, unsigned& nx) {
    const unsigned G = gridDim.x * gridDim.y * gridDim.z;
    unsigned sum, cnt, mine, sp = 0u;
    for (;;) {
        sum = 0u; cnt = 0u; mine = 0u;
#pragma unroll
        for (unsigned j = 0; j < 16; ++j) { const unsigned c = xb_ld(&bar[XB_XCNT(j)]); sum += c; cnt += (c > 0u) ? 1u : 0u; mine = (j == x) ? c : mine; }
        if (sum == G) break;
        __builtin_amdgcn_s_sleep(1);
        if ((++sp & 255u) == 0u) { if (xb_ld(&bar[XB_TMO])) break; if (sp > XB_SPIN_CAP) { atomicAdd(&bar[XB_TMO], 1u); break; } }
    }
    nloc = mine > 0u ? mine : 1u; nx = cnt > 0u ? cnt : 1u;
}
__device__ __forceinline__ void xcd_barrier(const XcdBarrier& b, const bool leader  ) {
    asm volatile("s_waitcnt vmcnt(0)" ::: "memory");
    __syncthreads();
    if (leader) {
        unsigned* bar = b.bar;
        __builtin_amdgcn_s_waitcnt(0);
        unsigned nloc = b.st[0], nx = b.st[1];
        if (nloc == 0u) { xcd_barrier_complete(bar, b.x, nloc, nx); b.st[0] = nloc; b.st[1] = nx; }
        const unsigned old = xb_add(&bar[XB_XSUB(b.x)], 1u);
        const unsigned gen = old / nloc;
        if (old + 1u == (gen + 1u) * nloc) {
            __builtin_amdgcn_fence(__ATOMIC_RELEASE, "agent");
            asm volatile("s_waitcnt vmcnt(0)" ::: "memory");
            const unsigned og = xb_add(&bar[XB_TOP], 1u);
            const unsigned tg = og / nx;
            if (og + 1u == (tg + 1u) * nx) xb_add(&bar[XB_TOPGEN], 1u);
            else XB_SPIN(xb_ld(&bar[XB_TOPGEN]) == tg, bar);
            xb_add(&bar[XB_XGEN(b.x)], 1u);
            __builtin_amdgcn_fence(__ATOMIC_ACQUIRE, "agent");
            asm volatile("s_waitcnt vmcnt(0)" ::: "memory");
        } else {
            XB_SPIN(xb_ld(&bar[XB_XGEN(b.x)]) == gen, bar);
            __builtin_amdgcn_fence(__ATOMIC_ACQUIRE, "agent");
            asm volatile("s_waitcnt vmcnt(0)" ::: "memory");
        }
    }
    __syncthreads();
}

constexpr int NWAVES = 8;
struct Args { const float* in[28]; float* out; unsigned char* ws; int ph_lo, ph_hi; };
struct Frame {
    LAS unsigned char* lds;
    volatile LAS unsigned* MISC;
    gu32* ctl;
    int tid, lane, wave, G;
    float* out; unsigned char* ws;
};
__device__ __forceinline__ float wave_sum(float v) {
    v = sum16(v); v = sum_r16(v); v = sum_r32(v);
    return v;
}

__device__ __forceinline__ void p0_transpose_item(const float* W, const float* gk, int K, int N, bf16* WT, int mode, LAS float* scr, int item, int lane) {
    const int nblk = N / 32, kb = item / nblk, nb = item % nblk, k0 = 64 * kb, n0 = 32 * nb;
    { f32x4 v[8]; float g[8];
#pragma unroll
      for (int i = 0; i < 8; ++i) { const int kk = 8 * i + (lane >> 3); v[i] = *(const GAS f32x4*)(W + (size_t)(k0 + kk) * N + n0 + 4 * (lane & 7)); g[i] = gk ? gk[k0 + kk] : 1.0f; }
#pragma unroll
      for (int i = 0; i < 8; ++i) { const int kk = 8 * i + (lane >> 3); LAS float* d = scr + kk * 33 + 4 * (lane & 7); d[0] = v[i].x * g[i]; d[1] = v[i].y * g[i]; d[2] = v[i].z * g[i]; d[3] = v[i].w * g[i]; } }
    LDS_WAIT(); asm volatile("" ::: "memory");
    const int c = lane & 7;
#pragma unroll
    for (int j = 0; j < 4; ++j) { const int n = n0 + (lane >> 3) + 8 * j; const LAS float* s = scr + (8 * c) * 33 + (n - n0);
        v4u o; o.x = pk2(s[0 * 33], s[1 * 33]); o.y = pk2(s[2 * 33], s[3 * 33]); o.z = pk2(s[4 * 33], s[5 * 33]); o.w = pk2(s[6 * 33], s[7 * 33]);
        const int drow = mode == 0 ? n : (256 * (n >> 7) + (n & 127) + (mode == 2 ? 128 : 0));
        *(GAS v4u*)(WT + (size_t)drow * K + k0 + 8 * c) = o; }
    LDS_WAIT(); asm volatile("" ::: "memory");
}
__constant__ int BUCKET_TH[15] = {22, 30, 40, 54, 73, 99, 134, 182, 246, 332, 450, 609, 825, 1117, 1513};
__device__ __forceinline__ float t2_value(const float* rel_bias, int h, int d) {
    const int m = (d <= 128 ? 1 : 0) + (((d & 3) == 0 && d <= 512) ? 1 : 0) + (((d & 15) == 0 && d <= 2048) ? 1 : 0);
    if (m == 0) return -__builtin_inff();
    int bucket = d;
    if (d >= 16) { bucket = 16; for (int k = 0; k < 15; ++k) bucket += (d >= BUCKET_TH[k]) ? 1 : 0; if (bucket > 31) bucket = 31; }
    const float lm = m == 1 ? 0.f : (m == 2 ? 0.6931471805599453f : 1.0986122886681098f);
    return (rel_bias[bucket * NH + h] + lm) * LOG2E;
}
__device__ __forceinline__ void p0_prologue(Frame& F, const Args& AR) {
    LAS float* scr = (LAS float*)(F.lds + F.wave * 16384);
    const int gw = blockIdx.x * NWAVES + F.wave, NGW = F.G * NWAVES;
    unsigned char* ws = F.ws;
    constexpr int I_GU = (DM / 64) * (DFF / 32), I_DN = (DFF / 64) * (DM / 32), I_IN = (DM / 64) * (NIN / 32), I_OUT = (DM / 64) * (DM / 32);
    constexpr int NITEMS = 4 * I_GU + 2 * I_DN + I_IN + I_OUT;
    for (int it = gw; it < NITEMS; it += NGW) {
        int r = it;
        if (r < I_GU) { p0_transpose_item(AR.in[7], AR.in[6], DM, DFF, (bf16*)(ws + WS_WGU1), 1, scr, r, F.lane); continue; } r -= I_GU;
        if (r < I_GU) { p0_transpose_item(AR.in[8], AR.in[6], DM, DFF, (bf16*)(ws + WS_WGU1), 2, scr, r, F.lane); continue; } r -= I_GU;
        if (r < I_DN) { p0_transpose_item(AR.in[9], nullptr, DFF, DM, (bf16*)(ws + WS_WD1), 0, scr, r, F.lane); continue; } r -= I_DN;
        if (r < I_GU) { p0_transpose_item(AR.in[24], AR.in[23], DM, DFF, (bf16*)(ws + WS_WGU2), 1, scr, r, F.lane); continue; } r -= I_GU;
        if (r < I_GU) { p0_transpose_item(AR.in[25], AR.in[23], DM, DFF, (bf16*)(ws + WS_WGU2), 2, scr, r, F.lane); continue; } r -= I_GU;
        if (r < I_DN) { p0_transpose_item(AR.in[26], nullptr, DFF, DM, (bf16*)(ws + WS_WD2), 0, scr, r, F.lane); continue; } r -= I_DN;
        if (r < I_IN) { p0_transpose_item(AR.in[11], AR.in[10], DM, NIN, (bf16*)(ws + WS_WIN), 0, scr, r, F.lane); continue; } r -= I_IN;
        { const int kb = r / (DM / 32); const float* gk = (64 * kb < AW) ? AR.in[20] : (AR.in[21] - AW);
          p0_transpose_item(AR.in[22], gk, DM, DM, (bf16*)(ws + WS_WOUT), 0, scr, r, F.lane); }
    }
    bf16* XA = (bf16*)(ws + WS_XA); float* rs1 = (float*)(ws + WS_RS1);
    for (int m0 = gw; m0 < MP + MS; m0 += 2 * NGW) {
        f32x4 v[2][8]; float s[2] = {0.f, 0.f};
#pragma unroll
        for (int q = 0; q < 2; ++q) { const int m = m0 + q * NGW; if (m < MP + MS) {
            const float* src = m < MP ? AR.in[0] + (size_t)m * DM : AR.in[1] + (size_t)(m - MP) * DM;
            const GAS f32x4* xr = (const GAS f32x4*)src + F.lane;
#pragma unroll
            for (int j = 0; j < 8; ++j) v[q][j] = xr[64 * j]; } }
#pragma unroll
        for (int q = 0; q < 2; ++q) { const int m = m0 + q * NGW; if (m < MP + MS) {
#pragma unroll
            for (int j = 0; j < 8; ++j) s[q] += (v[q][j].x * v[q][j].x + v[q][j].y * v[q][j].y) + (v[q][j].z * v[q][j].z + v[q][j].w * v[q][j].w);
            s[q] = wave_sum(s[q]);
            if (F.lane == 0) rs1[m] = 1.0f / sqrtf(s[q] * (1.0f / DM) + RMS_EPS);
            GAS unsigned long long* o8 = (GAS unsigned long long*)(XA + (size_t)m * DM) + F.lane;
#pragma unroll
            for (int j = 0; j < 8; ++j) o8[64 * j] = (unsigned long long)pk2(v[q][j].x, v[q][j].y) | ((unsigned long long)pk2(v[q][j].z, v[q][j].w) << 32); } }
    }
    const int gt = blockIdx.x * (NWAVES * 64) + F.tid, NGT = F.G * NWAVES * 64;
    float* ssq2 = (float*)(ws + WS_SSQ2); float* ssq3 = (float*)(ws + WS_SSQ3); float* ssq4 = (float*)(ws + WS_SSQ4);
    for (int i = gt; i < MPAD; i += NGT) { ssq2[i] = 0.f; ssq3[i] = 0.f; ssq4[i] = 0.f; }
    float* tbl = (float*)(ws + WS_TBL);
    for (int i = gt; i < NH * TBN; i += NGT) { const int h = i / TBN, j = i % TBN, d = 2048 - j; tbl[i] = d >= 0 ? t2_value(AR.in[19], h, d) : -__builtin_inff(); }
    bf16* wax = (bf16*)(ws + WS_WAX);
    for (int i = gt; i < 8 * 2 * 128 * 128; i += NGT) {
        const int j = i & 7, l = (i >> 3) & 63, kb = (i >> 9) & 3, w = (i >> 11) & 7, g = (i >> 14) & 1, n = i >> 15;
        const int k = 32 * kb + 8 * (l >> 4) + j, c = 16 * w + (l & 15);
        wax[i] = (bf16)f2bf((g ? AR.in[16] : AR.in[14])[((size_t)n * 128 + k) * 128 + c]);
    }
}

namespace at {
constexpr int SHM = 16384;
constexpr int TBW0 = 1504, TBWS = 834;
constexpr int V_OFF = 0, K_OFF = 2 * SHM, WSC_OFF = 4 * SHM, TB_OFF = WSC_OFF + 2048, FT_OFF = TB_OFF + 8 * TBWS * 4, LDS_END = FT_OFF + (132 + 196) * 4;
static_assert(LDS_END <= RING_BYTES, "attention lds");
#define KSWZ(row, colB) ((row) * 256 + ((colB) ^ (((row) & 7) << 4)))
__device__ __forceinline__ int v_st(int k, int c) { const int kk = (k & ~0xC) | ((k & 4) << 1) | ((k & 8) >> 1); return ((kk >> 3) * 4 + (c >> 5)) * 512 + ((kk & 7) * 32 + (c & 31)) * 2; }
__device__ __forceinline__ int v_rd_base(int lane) { return ((lane & 3) << 3) | (((lane >> 2) & 3) << 6) | (((lane >> 4) & 1) << 5) | (((lane >> 5) & 1) << 8); }
constexpr int v_rd_off(int d0, int ks, int half) { return d0 * 512 + ks * 4096 + half * 2048; }
__device__ __forceinline__ int crow(int r, int hi) { return (r & 3) + 8 * (r >> 2) + 4 * hi; }
__device__ __forceinline__ unsigned cvtpk(float lo, float hi) { unsigned r; asm volatile("v_cvt_pk_bf16_f32 %0, %1, %2" : "=v"(r) : "v"(lo), "v"(hi)); return r; }

constexpr float SM_THR = 11.0f;
__device__ __forceinline__ void partialSM(f32x16& p0, f32x16& p1, float& m_reg, float l_reg, float& delta, float& alpha) {
    float pmax = p0[0];
#pragma unroll
    for (int r = 1; r < 16; ++r) pmax = fmaxf(pmax, p0[r]);
#pragma unroll
    for (int r = 0; r < 16; ++r) pmax = fmaxf(pmax, p1[r]);
    { auto rr = __builtin_amdgcn_permlane32_swap(__float_as_uint(pmax), __float_as_uint(pmax), false, false);
      pmax = fmaxf(__uint_as_float(rr[0]), __uint_as_float(rr[1])); }
    const bool need = (pmax > SM_THR) || (l_reg == 0.f && pmax < -SM_THR && pmax > -__builtin_inff());
    if (!__any(need)) { delta = 0.f; alpha = 1.f;
#pragma unroll
        for (int r = 0; r < 16; ++r) p0[r] = __builtin_amdgcn_exp2f(p0[r]);
    } else { delta = need ? pmax : 0.f; alpha = __builtin_amdgcn_exp2f(-delta); m_reg += delta;
#pragma unroll
        for (int r = 0; r < 16; ++r) p0[r] = __builtin_amdgcn_exp2f(p0[r] - delta); }
}
__device__ __forceinline__ void finishSM(f32x16& p0, f32x16& p1, float delta, float alpha, float& l_reg, bf16x8& pa0, bf16x8& pa1, bf16x8& pa2, bf16x8& pa3) {
    if (__all(delta == 0.f)) {
#pragma unroll
        for (int r = 0; r < 16; ++r) p1[r] = __builtin_amdgcn_exp2f(p1[r]);
    } else {
#pragma unroll
        for (int r = 0; r < 16; ++r) p1[r] = __builtin_amdgcn_exp2f(p1[r] - delta); }
    float ps = 0;
#pragma unroll
    for (int r = 0; r < 16; ++r) ps += p0[r];
#pragma unroll
    for (int r = 0; r < 16; ++r) ps += p1[r];
    { auto rr = __builtin_amdgcn_permlane32_swap(__float_as_uint(ps), __float_as_uint(ps), false, false);
      ps = __uint_as_float(rr[0]) + __uint_as_float(rr[1]); }
    l_reg = l_reg * alpha + ps;
#define PK4(P, B_, OUT) do { unsigned a0 = cvtpk(P[B_+0], P[B_+1]), a1 = cvtpk(P[B_+2], P[B_+3]);                          \
        unsigned b0 = cvtpk(P[B_+4], P[B_+5]), b1 = cvtpk(P[B_+6], P[B_+7]);                                             \
        auto r0 = __builtin_amdgcn_permlane32_swap(a0, b0, false, false); auto r1 = __builtin_amdgcn_permlane32_swap(a1, b1, false, false); \
        v4u w = {r0[0], r1[0], r0[1], r1[1]}; OUT = __builtin_bit_cast(bf16x8, w); } while (0)
    PK4(p0, 0, pa0); PK4(p0, 8, pa1); PK4(p1, 0, pa2); PK4(p1, 8, pa3);
#undef PK4
}
template <int KB>
__device__ __forceinline__ void qkt(f32x16& p0, f32x16& p1, const LAS char* K_lds, int r32, int hi, const bf16x8* qr, const LAS float* tb, float mref) {
    unsigned ka[4];
#pragma unroll
    for (int dd = 0; dd < 4; ++dd) ka[dd] = (unsigned)(uintptr_t)(K_lds + KSWZ(r32, (dd * 16 + hi * 8) * 2));
#define KRD(dst, d0_, half_) asm volatile("ds_read_b128 %0, %1 offset:%2" : "=&v"(dst) : "v"(ka[(d0_) & 3]), "i"(KB * SHM + ((d0_) >> 2) * 128 + (half_) * 8192) : "memory")
#define KSTEP(d0_, cur_, nxt_, WAITN) do { if ((d0_) + 2 < 8) { KRD(kl[nxt_], (d0_) + 2, 0); KRD(kh[nxt_], (d0_) + 2, 1); } \
        asm volatile("s_waitcnt lgkmcnt(" #WAITN ")" ::: "memory"); __builtin_amdgcn_sched_barrier(0); \
        p0 = __builtin_amdgcn_mfma_f32_32x32x16_bf16(kl[cur_], qr[d0_], p0, 0, 0, 0); p1 = __builtin_amdgcn_mfma_f32_32x32x16_bf16(kh[cur_], qr[d0_], p1, 0, 0, 0); } while (0)
    bf16x8 kl[3], kh[3];
    KRD(kl[0], 0, 0); KRD(kh[0], 0, 1); KRD(kl[1], 1, 0); KRD(kh[1], 1, 1);
#pragma unroll
    for (int r = 0; r < 16; ++r) { const int c = (r & 3) + 8 * (r >> 2); p0[r] = tb[c] - mref; p1[r] = tb[c + 32] - mref; }
    asm volatile("s_waitcnt lgkmcnt(0)" ::: "memory"); __builtin_amdgcn_sched_barrier(0);
    KSTEP(0, 0, 2, 2); KSTEP(1, 1, 0, 2); KSTEP(2, 2, 1, 4); KSTEP(3, 0, 2, 4); KSTEP(4, 1, 0, 4); KSTEP(5, 2, 1, 4); KSTEP(6, 0, 2, 2); KSTEP(7, 1, 0, 0);
#undef KSTEP
#undef KRD
}
template <int VB>
__device__ __forceinline__ void pv_tile(f32x16* o, unsigned vb0, bf16x8 pa0, bf16x8 pa1, bf16x8 pa2, bf16x8 pa3) {
#define TRRD(dst, off) asm volatile("ds_read_b64_tr_b16 %0, %1 offset:%2" : "=&v"(dst) : "v"(vb0), "i"(off) : "memory")
#define PV_RD(S, d0) do { constexpr int b_ = VB * SHM + v_rd_off(d0, 0, 0); \
        TRRD(S[0], b_); TRRD(S[1], b_ + 2048); TRRD(S[2], b_ + 4096); TRRD(S[3], b_ + 6144); TRRD(S[4], b_ + 8192); TRRD(S[5], b_ + 10240); TRRD(S[6], b_ + 12288); TRRD(S[7], b_ + 14336); } while (0)
#define PV_MM(S, d0) do { \
        o[d0] = __builtin_amdgcn_mfma_f32_32x32x16_bf16(pa0, (bf16x8){S[0][0], S[0][1], S[0][2], S[0][3], S[1][0], S[1][1], S[1][2], S[1][3]}, o[d0], 0, 0, 0);   \
        o[d0] = __builtin_amdgcn_mfma_f32_32x32x16_bf16(pa1, (bf16x8){S[2][0], S[2][1], S[2][2], S[2][3], S[3][0], S[3][1], S[3][2], S[3][3]}, o[d0], 0, 0, 0);   \
        o[d0] = __builtin_amdgcn_mfma_f32_32x32x16_bf16(pa2, (bf16x8){S[4][0], S[4][1], S[4][2], S[4][3], S[5][0], S[5][1], S[5][2], S[5][3]}, o[d0], 0, 0, 0);   \
        o[d0] = __builtin_amdgcn_mfma_f32_32x32x16_bf16(pa3, (bf16x8){S[6][0], S[6][1], S[6][2], S[6][3], S[7][0], S[7][1], S[7][2], S[7][3]}, o[d0], 0, 0, 0); } while (0)
#define PV_WAIT(N) do { asm volatile("s_waitcnt lgkmcnt(" #N ")" ::: "memory"); __builtin_amdgcn_sched_barrier(0); } while (0)
    s16x4 A[8], B[8];
    PV_RD(A, 0);
    PV_RD(B, 1); PV_WAIT(8); PV_MM(A, 0);
    PV_RD(A, 2); PV_WAIT(8); PV_MM(B, 1);
    PV_RD(B, 3); PV_WAIT(8); PV_MM(A, 2);
    PV_WAIT(0); PV_MM(B, 3);
#undef PV_RD
#undef PV_MM
#undef PV_WAIT
#undef TRRD
}
__device__ __forceinline__ void far_softmax(f32x16& p0, float& m_reg, float& l_reg, float& alpha, bf16x8& pa0, bf16x8& pa1) {
    float pmax = p0[0];
#pragma unroll
    for (int r = 1; r < 16; ++r) pmax = fmaxf(pmax, p0[r]);
    { auto rr = __builtin_amdgcn_permlane32_swap(__float_as_uint(pmax), __float_as_uint(pmax), false, false);
      pmax = fmaxf(__uint_as_float(rr[0]), __uint_as_float(rr[1])); }
    const bool need = (pmax > SM_THR) || (l_reg == 0.f && pmax < -SM_THR && pmax > -__builtin_inff());
    float delta = 0.f; alpha = 1.f;
    if (__any(need)) { delta = need ? pmax : 0.f; alpha = __builtin_amdgcn_exp2f(-delta); m_reg += delta; }
    float ps = 0.f;
#pragma unroll
    for (int r = 0; r < 16; ++r) { p0[r] = __builtin_amdgcn_exp2f(p0[r] - delta); ps += p0[r]; }
    { auto rr = __builtin_amdgcn_permlane32_swap(__float_as_uint(ps), __float_as_uint(ps), false, false);
      ps = __uint_as_float(rr[0]) + __uint_as_float(rr[1]); }
    l_reg = l_reg * alpha + ps;
#define PK4(P, B_, OUT) do { unsigned a0 = cvtpk(P[B_+0], P[B_+1]), a1 = cvtpk(P[B_+2], P[B_+3]);                          \
        unsigned b0 = cvtpk(P[B_+4], P[B_+5]), b1 = cvtpk(P[B_+6], P[B_+7]);                                             \
        auto r0 = __builtin_amdgcn_permlane32_swap(a0, b0, false, false); auto r1 = __builtin_amdgcn_permlane32_swap(a1, b1, false, false); \
        v4u w = {r0[0], r1[0], r0[1], r1[1]}; OUT = __builtin_bit_cast(bf16x8, w); } while (0)
    PK4(p0, 0, pa0); PK4(p0, 8, pa1);
#undef PK4
}
}

__device__ __forceinline__ void attn_unit(Frame& F, int b, int h, int qb) {
    using namespace at;
    int tid = F.tid, lane = F.lane; asm volatile("" : "+v"(tid), "+v"(lane));
    const int wid = F.wave, r32 = lane & 31, hi = lane >> 5;
    LAS char* V_lds = (LAS char*)F.lds + V_OFF; LAS char* K_lds = (LAS char*)F.lds + K_OFF;
    LAS float* wsc = (LAS float*)(F.lds + WSC_OFF) + wid * 64; LAS float* li_l = wsc; LAS float* al_l = wsc + 32;
    LAS float* TB = (LAS float*)(F.lds + TB_OFF);
    const int P0 = qb * 256, NT = 4 * (qb + 1), rowbase = b * SP;
    const float* gt = (const float*)(F.ws + WS_TBL) + h * TBN;
    for (int i = tid; i < 8 * TBWS; i += NWAVES * 64) { const int k = i / TBWS, e_ = i - k * TBWS; TB[i] = gt[TBW0 + e_ - 32 * k]; }
    LAS float* FT = (LAS float*)(F.lds + FT_OFF);
    for (int i = tid; i < 129; i += NWAVES * 64) FT[i] = gt[2048 - 16 * i];
    LAS float* FT4 = FT + 132;
    for (int i = tid; i < 196; i += NWAVES * 64) FT4[i] = gt[2048 - 4 * i];
    const int qrow = 16 * (r32 & 15) + 2 * wid + (r32 >> 4), qpos = P0 + qrow;
    const bf16* Qp = (const bf16*)(F.ws + WS_Q) + (size_t)(rowbase + qpos) * AW + h * HD + hi * 8;
    bf16x8 qr[8];
#pragma unroll
    for (int d0 = 0; d0 < 8; ++d0) qr[d0] = *(const bf16x8*)(Qp + d0 * 16);
    float m_reg = 0.f, l_reg = 0.f; f32x16 o[4] = {};
    f32x16 p0, p1; float mn, alpha; bf16x8 pa0, pa1, pa2, pa3;
#define A_RESC() do { if (__any(alpha < 1.f)) { if (hi == 0) al_l[r32] = alpha; LDS_WAIT(); \
            _Pragma("unroll") for (int d_ = 0; d_ < 4; ++d_) _Pragma("unroll") for (int r = 0; r < 16; ++r) o[d_][r] *= al_l[crow(r, hi)]; } } while (0)
    __syncthreads();
    if (qb >= 3) {
        LAS char* fv = (LAS char*)F.lds + wid * 8192;
        const unsigned fvb = (unsigned)(uintptr_t)fv + (unsigned)v_rd_base(lane);
        const int eq = r32 >> 4;
        const bf16* Kf = (const bf16*)(F.ws + WS_KB) + (size_t)(rowbase + 16 * (r32 & 15) + 2 * wid + (r32 >> 4)) * AW + h * HD + hi * 8;
        const bf16* Vf = (const bf16*)(F.ws + WS_VB) + (size_t)(rowbase + 2 * wid) * AW + h * HD;
        const LAS float* tbf = FT + (16 * qb + (r32 & 15) - 4 * hi);
        bf16x8 kf[8], vch[8];
#define FAR_LOADK(f_) do { _Pragma("unroll") for (int d0 = 0; d0 < 8; ++d0) kf[d0] = *(const bf16x8*)(Kf + (size_t)(256 * (f_)) * AW + d0 * 16); } while (0)
#define FAR_LOADV(f_) do { _Pragma("unroll") for (int i = 0; i < 8; ++i) { const int q = lane + 64 * i, rho = q >> 4, chn = q & 15; \
                vch[i] = *(const bf16x8*)(Vf + (size_t)(256 * (f_) + 16 * (rho & 15) + (rho >> 4)) * AW + 8 * chn); } } while (0)
        FAR_LOADK(0); FAR_LOADV(0);
        for (int f = 0; f < qb - 2; ++f) {
#pragma unroll
            for (int r = 0; r < 8; ++r) { const int kk0 = (r & 3) + 8 * ((r >> 2) & 1); const float bias = tbf[-16 * f - kk0] - m_reg;
                p0[r] = (eq == 0) ? bias : -__builtin_inff();
                p0[r + 8] = (eq == 1) ? bias : -__builtin_inff(); }
#pragma unroll
            for (int d0 = 0; d0 < 8; ++d0) p0 = __builtin_amdgcn_mfma_f32_32x32x16_bf16(kf[d0], qr[d0], p0, 0, 0, 0);
            asm volatile("" : "+v"(p0));
            if (f + 1 < qb - 2) FAR_LOADK(f + 1);
#pragma unroll
            for (int i = 0; i < 8; ++i) { const int q = lane + 64 * i, rho = q >> 4, chn = q & 15; *(LAS bf16x8*)(fv + v_st(rho, 8 * chn)) = vch[i]; }
            asm volatile("" ::: "memory");
            if (f + 1 < qb - 2) FAR_LOADV(f + 1);
            far_softmax(p0, m_reg, l_reg, alpha, pa0, pa1);
            A_RESC();
            LDS_WAIT();
#define TRRD(dst, off) asm volatile("ds_read_b64_tr_b16 %0, %1 offset:%2" : "=&v"(dst) : "v"(fvb), "i"(off) : "memory")
#define FPV(d0) do { s16x4 l0, h0, l1, h1; constexpr int b_ = v_rd_off(d0, 0, 0); TRRD(l0, b_); TRRD(h0, b_ + 2048); TRRD(l1, b_ + 4096); TRRD(h1, b_ + 6144); \
                asm volatile("s_waitcnt lgkmcnt(0)" ::: "memory"); __builtin_amdgcn_sched_barrier(0); \
                o[d0] = __builtin_amdgcn_mfma_f32_32x32x16_bf16(pa0, (bf16x8){l0[0], l0[1], l0[2], l0[3], h0[0], h0[1], h0[2], h0[3]}, o[d0], 0, 0, 0); \
                o[d0] = __builtin_amdgcn_mfma_f32_32x32x16_bf16(pa1, (bf16x8){l1[0], l1[1], l1[2], l1[3], h1[0], h1[1], h1[2], h1[3]}, o[d0], 0, 0, 0); } while (0)
            FPV(0); FPV(1); FPV(2); FPV(3);
#undef FPV
#undef TRRD
        }
#undef FAR_LOADK
#undef FAR_LOADV
    }
    __syncthreads();
    const int kb_lo = P0 > 512 ? P0 - 512 : 0;
    const int nmid = P0 >= 128 ? (P0 - 128 - kb_lo) >> 6 : 0;
    const int t_lo = qb >= 1 ? 4 * qb - 2 : 0;
    const int sr = tid >> 4, sc = (tid & 15) * 8, vst0 = v_st(sr, sc), vst1 = v_st(32 + sr, sc), kws = KSWZ(sr, sc * 2), mra = 4 * (sr & 15) + (sr >> 4);
    const bf16* Kp = (const bf16*)(F.ws + WS_KB) + (size_t)rowbase * AW + h * HD + sc;
    const bf16* Vp = (const bf16*)(F.ws + WS_VB) + (size_t)rowbase * AW + h * HD + sc;
    bf16x8 st_k0, st_k1, st_v0, st_v1;
#define A_LOAD(n_) do { const int n__ = (n_); const bool md_ = n__ < nmid; const int kb_ = md_ ? kb_lo + 64 * n__ : 64 * (t_lo + n__ - nmid); \
                         const int ra_ = kb_ + (md_ ? mra : sr), rb_ = kb_ + (md_ ? mra + 2 : sr + 32); \
                         st_k0 = *(const bf16x8*)(Kp + (size_t)ra_ * AW); st_k1 = *(const bf16x8*)(Kp + (size_t)rb_ * AW); \
                         st_v0 = *(const bf16x8*)(Vp + (size_t)ra_ * AW); st_v1 = *(const bf16x8*)(Vp + (size_t)rb_ * AW); } while (0)
#define A_WRITE(bf) do { *(LAS bf16x8*)(K_lds + (bf) * SHM + kws) = st_k0; *(LAS bf16x8*)(K_lds + (bf) * SHM + kws + 32 * 256) = st_k1; \
                         *(LAS bf16x8*)(V_lds + (bf) * SHM + vst0) = st_v0; *(LAS bf16x8*)(V_lds + (bf) * SHM + vst1) = st_v1; } while (0)
    A_LOAD(0); A_WRITE(0);
    __syncthreads();
    const unsigned vb0 = (unsigned)(uintptr_t)V_lds + (unsigned)v_rd_base(lane);
    int n = 0;
    if (nmid > 0) {
        const int eq = r32 >> 4, c0 = (2 * wid) & 3, c1 = (2 * wid + 1) & 3;
        const int rowsel = 16 * (eq ? c1 : c0) + (r32 & 15);
        int kam[4];
#pragma unroll
        for (int dd = 0; dd < 4; ++dd) kam[dd] = KSWZ(rowsel, (dd * 16 + hi * 8) * 2);
        const unsigned vbm0 = vb0 + 4096u * (unsigned)c0, vbm1 = vb0 + 4096u * (unsigned)c1;
        const LAS float* tbm = FT4 + ((P0 - kb_lo) / 4 + 4 * (r32 & 15) + ((2 * wid + eq) >> 2) - 4 * hi);
#define TRRD(dst, base, off) asm volatile("ds_read_b64_tr_b16 %0, %1 offset:%2" : "=&v"(dst) : "v"(base), "i"(off) : "memory")
#define MPV(bf, d0) do { s16x4 l0, h0, l1, h1; constexpr int b_ = (bf) * SHM + v_rd_off(d0, 0, 0); TRRD(l0, vbm0, b_); TRRD(h0, vbm0, b_ + 2048); TRRD(l1, vbm1, b_); TRRD(h1, vbm1, b_ + 2048); \
            asm volatile("s_waitcnt lgkmcnt(0)" ::: "memory"); __builtin_amdgcn_sched_barrier(0); \
            o[d0] = __builtin_amdgcn_mfma_f32_32x32x16_bf16(pa0, (bf16x8){l0[0], l0[1], l0[2], l0[3], h0[0], h0[1], h0[2], h0[3]}, o[d0], 0, 0, 0); \
            o[d0] = __builtin_amdgcn_mfma_f32_32x32x16_bf16(pa1, (bf16x8){l1[0], l1[1], l1[2], l1[3], h1[0], h1[1], h1[2], h1[3]}, o[d0], 0, 0, 0); } while (0)
#define M_STEP(n_, bf) do { \
            A_LOAD((n_) + 1);                                   \
            bf16x8 kf[8]; \
            _Pragma("unroll") for (int d0 = 0; d0 < 8; ++d0) kf[d0] = *(const LAS bf16x8*)(K_lds + (bf) * SHM + kam[d0 & 3] + (d0 >> 2) * 128); \
            _Pragma("unroll") for (int r = 0; r < 8; ++r) { const int kk0 = (r & 3) + 8 * ((r >> 2) & 1); const float bias = tbm[-16 * (n_) - kk0] - m_reg; \
                p0[r] = (eq == 0) ? bias : -__builtin_inff(); p0[r + 8] = (eq == 1) ? bias : -__builtin_inff(); } \
            _Pragma("unroll") for (int d0 = 0; d0 < 8; ++d0) p0 = __builtin_amdgcn_mfma_f32_32x32x16_bf16(kf[d0], qr[d0], p0, 0, 0, 0); \
            far_softmax(p0, m_reg, l_reg, alpha, pa0, pa1); \
            A_RESC(); \
            MPV(bf, 0); MPV(bf, 1); MPV(bf, 2); MPV(bf, 3); \
            A_WRITE((bf) ^ 1); \
            __syncthreads(); } while (0)
        for (; n < nmid; n += 2) { M_STEP(n, 0); M_STEP(n + 1, 1); }
#undef M_STEP
#undef MPV
#undef TRRD
    }
    const LAS float* tbq = TB + ((r32 & 15) >> 1) * TBWS + (2048 - P0 - 2 * wid - (r32 >> 4) + 4 * hi - TBW0 - 16 * (r32 & 1));
#define A_STEP(n_, t, bf) do { \
        if ((t) + 1 < NT) A_LOAD((n_) + 1); \
        qkt<bf>(p0, p1, K_lds, r32, hi, qr, tbq + (t) * 64, m_reg); \
        partialSM(p0, p1, m_reg, l_reg, mn, alpha);        \
        A_RESC(); \
        finishSM(p0, p1, mn, alpha, l_reg, pa0, pa1, pa2, pa3); \
        pv_tile<bf>(o, vb0, pa0, pa1, pa2, pa3); \
        if ((t) + 1 < NT) A_WRITE((bf) ^ 1); \
        __syncthreads(); } while (0)
    for (int t = t_lo; t < NT; t += 2, n += 2) { A_STEP(n, t, 0); A_STEP(n + 1, t + 1, 1); }
#undef A_STEP
#undef A_LOAD
#undef A_WRITE
#undef A_RESC
    if (hi == 0) li_l[r32] = l_reg;
    LDS_WAIT();
    bf16* Ow = (bf16*)(F.ws + WS_GRP) + (size_t)(rowbase + P0 + 2 * wid) * DM + h * HD;
    float* ssqa = (float*)(F.ws + WS_SSQA) + (size_t)(rowbase + P0 + 2 * wid) * 8 + h;
#pragma unroll
    for (int r = 0; r < 16; ++r) {
        const int rr = crow(r, hi), orow = 16 * (rr & 15) + (rr >> 4); const float rl = 1.0f / li_l[rr]; float sq = 0.f;
#pragma unroll
        for (int d0 = 0; d0 < 4; ++d0) { const float v = o[d0][r] * rl; sq += v * v; const float vn = dppf<0xB1>(v);
            if ((r32 & 1) == 0) *(unsigned*)(Ow + (size_t)orow * DM + d0 * 32 + r32) = cvtpk(v, vn); }
        sq = sum16(sq); sq = sum_r16(sq);
        if (r32 == 0) ssqa[(size_t)orow * 8] = sq;
    }
    __syncthreads();
}

__device__ __forceinline__ void sattn_unit(Frame& F, const Args& AR, int b, int h) {
    int lane = F.lane; asm volatile("" : "+v"(lane));
    const int wid = F.wave, t = lane >> 4, seg = lane & 15;
    const int row = MP + TS * b + t;
    const bf16* qp = (const bf16*)(F.ws + WS_Q) + (size_t)row * AW + h * HD + 8 * seg;
    float qf[8];
    { const v4u qv = *(const v4u*)qp; const unsigned qw[4] = {qv.x, qv.y, qv.z, qv.w};
#pragma unroll
      for (int j = 0; j < 4; ++j) { qf[2 * j] = bf2f((unsigned short)(qw[j] & 0xffffu)); qf[2 * j + 1] = bf2f((unsigned short)(qw[j] >> 16)); } }
    const float* ck = AR.in[2]; const float* cv = AR.in[3];
    const float* gt = (const float*)(F.ws + WS_TBL) + h * TBN;
    float m = -1e30f, l = 0.f, acc[8];
#pragma unroll
    for (int j = 0; j < 8; ++j) acc[j] = 0.f;
#define SA_LOAD(K0, K1, V0, V1, TB_, di_raw_, valid_) do { const int di = (di_raw_); \
            const int d = di < 129 ? di : (di < 225 ? 128 + 4 * (di - 128) : 512 + 16 * (di - 224)); \
            const int i = 2048 + t - d; \
            const float* kp; const float* vp; \
            if (i < 2048) { const size_t off = (((size_t)b * 2048 + i) * NH + h) * HD + 8 * seg; kp = ck + off; vp = cv + off; } \
            else { const size_t off = (size_t)(TS * b + (i - 2048)) * AW + h * HD + 8 * seg; kp = F.out + OFF_KS + off; vp = F.out + OFF_VS + off; } \
            K0 = *(const f32x4*)kp; K1 = *(const f32x4*)(kp + 4); V0 = *(const f32x4*)vp; V1 = *(const f32x4*)(vp + 4); \
            TB_ = (valid_) ? gt[2048 - d] : -__builtin_inff(); } while (0)
#define SA_ACC(K0, K1, V0, V1, TB_) do { \
            float dot = ((qf[0] * K0[0] + qf[1] * K0[1]) + (qf[2] * K0[2] + qf[3] * K0[3])) + ((qf[4] * K1[0] + qf[5] * K1[1]) + (qf[6] * K1[2] + qf[7] * K1[3])); \
            dot = sum16(dot); \
            const float s2 = dot + TB_;                                      \
            const float mn = fmaxf(m, s2), al = __builtin_amdgcn_exp2f(m - mn), p = __builtin_amdgcn_exp2f(s2 - mn); \
            l = l * al + p; m = mn; \
            _Pragma("unroll") for (int j = 0; j < 4; ++j) { acc[j] = acc[j] * al + p * V0[j]; acc[4 + j] = acc[4 + j] * al + p * V1[j]; } } while (0)
    f32x4 ke0, ke1, ve0, ve1; float tbe;
    SA_LOAD(ke0, ke1, ve0, ve1, tbe, 320, wid == 0);
    for (int k0 = 0; k0 < 40; k0 += 8) {
        f32x4 k0v[8], k1v[8], v0v[8], v1v[8]; float tb[8];
#pragma unroll
        for (int u = 0; u < 8; ++u) SA_LOAD(k0v[u], k1v[u], v0v[u], v1v[u], tb[u], wid + NWAVES * (k0 + u), true);
#pragma unroll
        for (int u = 0; u < 8; ++u) SA_ACC(k0v[u], k1v[u], v0v[u], v1v[u], tb[u]);
    }
    SA_ACC(ke0, ke1, ve0, ve1, tbe);
#undef SA_LOAD
#undef SA_ACC
    LAS float* sm = (LAS float*)F.lds;
    { LAS float* s = sm + (wid * 64 + lane) * 10; s[0] = m; s[1] = l;
#pragma unroll
      for (int j = 0; j < 8; ++j) s[2 + j] = acc[j]; }
    __syncthreads();
    if (wid == 0) {
        float M = -1e30f;
#pragma unroll
        for (int w = 0; w < NWAVES; ++w) M = fmaxf(M, sm[(w * 64 + lane) * 10]);
        float L = 0.f, O[8];
#pragma unroll
        for (int j = 0; j < 8; ++j) O[j] = 0.f;
#pragma unroll
        for (int w = 0; w < NWAVES; ++w) { const LAS float* s = sm + (w * 64 + lane) * 10; const float e = __builtin_amdgcn_exp2f(s[0] - M); L += s[1] * e;
#pragma unroll
            for (int j = 0; j < 8; ++j) O[j] += s[2 + j] * e; }
        const float rl = 1.0f / L; float sq = 0.f;
#pragma unroll
        for (int j = 0; j < 8; ++j) { O[j] *= rl; sq += O[j] * O[j]; }
        v4u w4; w4.x = pk2(O[0], O[1]); w4.y = pk2(O[2], O[3]); w4.z = pk2(O[4], O[5]); w4.w = pk2(O[6], O[7]);
        *(v4u*)((bf16*)(F.ws + WS_GRP) + (size_t)row * DM + h * HD + 8 * seg) = w4;
        sq = sum16(sq);
        if (seg == 0) ((float*)(F.ws + WS_SSQA))[(size_t)row * 8 + h] = sq;
    }
    __syncthreads();
}

namespace lru {
constexpr int TS_ = 272;
constexpr int UB_OFF = 0, GT_OFF = 2 * 64 * TS_  , YT_OFF = 4 * 64 * TS_  , LDS_END = 6 * 64 * TS_;
static_assert(LDS_END <= RING_BYTES, "lru lds");
}
__device__ __forceinline__ void lru_unit(Frame& F, const Args& AR, int rowbase, int T, int n, const float* prefix, const float* h0, float* conv_out, float* h_out) {
    using namespace lru;
    int tid = F.tid, l = F.lane; asm volatile("" : "+v"(tid), "+v"(l));
    const int w = F.wave, cl = l & 15, tq = l >> 4;
    const int chl = 16 * w + cl, ch = 128 * n + chl;
    const float ba2 = AR.in[15][ch] * -LOG2E, bx2 = AR.in[17][ch] * -LOG2E;
    const float lam = AR.in[18][ch];
    const float LA2 = -8.0f * log1pf(expf(-lam)) * LOG2E;
    float hc = h0 ? h0[ch] : 0.f;
    bf16x8 bfa[4], bfx[4];
    { const bf16* wax = (const bf16*)(F.ws + WS_WAX);
#pragma unroll
      for (int kb = 0; kb < 4; ++kb) { bfa[kb] = *(const bf16x8*)(wax + ((size_t)((((n * 2 + 0) * 8 + w) * 4 + kb) * 64 + l)) * 8);
                                       bfx[kb] = *(const bf16x8*)(wax + ((size_t)((((n * 2 + 1) * 8 + w) * 4 + kb) * 64 + l)) * 8); } }
    const int c4 = tid & 31, tr = tid >> 5;
    const int cg = 128 * n + 4 * c4;
    f32x4 cw[4];
#pragma unroll
    for (int j = 0; j < 4; ++j) cw[j] = *(const f32x4*)(AR.in[12] + j * AW + cg);
    const f32x4 cb = *(const f32x4*)(AR.in[13] + cg);
    const bf16* XL = (const bf16*)(F.ws + WS_XL);
    const bf16* GG = (const bf16*)(F.ws + WS_GG);
    bf16* YL = (bf16*)(F.ws + WS_GRP) + AW;
    float* ssql = (float*)(F.ws + WS_SSQL);
    const int io_row = tid >> 4, io_c8 = (tid & 15) * 8;
    f32x4 x[7]; v4u gch[2];
    const bf16* xlp = XL + ((size_t)rowbase + 4 * tr - 3) * AW + cg;
    const bf16* ggp = GG + ((size_t)rowbase + io_row) * AW + 128 * n + io_c8;
    bf16* ylp = YL + ((size_t)rowbase + io_row) * DM + 128 * n + io_c8;
    float* sqp = ssql + ((size_t)rowbase + io_row) * 8 + n;
#define LRU_X4(w_) ((f32x4){__builtin_bit_cast(float, (w_).x << 16), __builtin_bit_cast(float, (w_).x & 0xffff0000u), __builtin_bit_cast(float, (w_).y << 16), __builtin_bit_cast(float, (w_).y & 0xffff0000u)})
#define LRU_LOADX(sc_) do { if ((sc_) >= 64 && (sc_) + 64 <= T) {              \
            _Pragma("unroll") for (int r = 0; r < 7; ++r) { const v2u w_ = *(const v2u*)(xlp + (size_t)((sc_) + r) * AW); x[r] = LRU_X4(w_); } \
            gch[0] = *(const v4u*)(ggp + (size_t)(sc_) * AW); gch[1] = *(const v4u*)(ggp + (size_t)((sc_) + 32) * AW); \
        } else { \
            _Pragma("unroll") for (int r = 0; r < 7; ++r) { const int tt = (sc_) + 4 * tr - 3 + r; \
                if (tt < 0) x[r] = prefix ? *(const f32x4*)(prefix + (3 + tt) * AW + cg) : (f32x4){0.f, 0.f, 0.f, 0.f}; \
                else if (tt < T) { const v2u w_ = *(const v2u*)(xlp + (size_t)((sc_) + r) * AW); x[r] = LRU_X4(w_); } \
                else x[r] = (f32x4){0.f, 0.f, 0.f, 0.f}; } \
            _Pragma("unroll") for (int k = 0; k < 2; ++k) { const int t_ = (sc_) + io_row + 32 * k; gch[k] = t_ < T ? *(const v4u*)(ggp + (size_t)((sc_) + 32 * k) * AW) : (v4u){0u, 0u, 0u, 0u}; } } } while (0)
#define LRU_CONVW(buf_, sc_) do { LAS unsigned char* UBw = F.lds + UB_OFF + (buf_) * 64 * TS_; LAS unsigned char* GTw = F.lds + GT_OFF + (buf_) * 64 * TS_; \
        _Pragma("unroll") for (int i = 0; i < 4; ++i) { const int tl = 4 * tr + i; \
            const f32x4 u = cb + cw[0] * x[i] + cw[1] * x[i + 1] + cw[2] * x[i + 2] + cw[3] * x[i + 3]; \
            v2u ub; ub.x = pg8::cvt_pk_bf16(u[0], u[1]); ub.y = pg8::cvt_pk_bf16(u[2], u[3]); \
            *(LAS v2u*)(UBw + tl * TS_ + 8 * c4) = ub; } \
        if ((sc_) + 64 >= T) { _Pragma("unroll") for (int i = 0; i < 4; ++i) { const int t = (sc_) + 4 * tr + i; if (t < T && t >= T - 3) *(f32x4*)(conv_out + (t - (T - 3)) * AW + cg) = x[i + 3]; } } \
        _Pragma("unroll") for (int k = 0; k < 2; ++k) *(LAS v4u*)(GTw + (io_row + 32 * k) * TS_ + 2 * io_c8) = gch[k]; } while (0)
#define LRU_FLUSH(buf_, sc_) do { const LAS unsigned char* YTr = F.lds + YT_OFF + (buf_) * 64 * TS_; \
        _Pragma("unroll") for (int k = 0; k < 2; ++k) { const int row_ = io_row + 32 * k, t_ = (sc_) + row_; const v4u yv = *(const LAS v4u*)(YTr + row_ * TS_ + 2 * io_c8); \
            const unsigned yw[4] = {yv.x, yv.y, yv.z, yv.w}; float sq = 0.f; \
            _Pragma("unroll") for (int j = 0; j < 4; ++j) { const float a_ = __builtin_bit_cast(float, yw[j] << 16), b_ = __builtin_bit_cast(float, yw[j] & 0xffff0000u); sq += a_ * a_ + b_ * b_; } \
            sq = sum16(sq); \
            if (t_ < T) { *(v4u*)(ylp + (size_t)((sc_) + 32 * k) * DM) = yv; if ((tid & 15) == 0) sqp[(size_t)((sc_) + 32 * k) * 8] = sq; } } } while (0)
    const int nsc = (T + 63) >> 6;
    float hlast = 0.f;
    LRU_LOADX(0); LRU_CONVW(0, 0);
    __syncthreads();
    for (int s = 0; s < nsc; ++s) {
        const int sc = 64 * s, cur = s & 1;
        const bool more = s + 1 < nsc, lastsc = !more;
        if (more) LRU_LOADX(sc + 64);
        if (s > 0) LRU_FLUSH(cur ^ 1, sc - 64);
        const LAS unsigned char* UB = F.lds + UB_OFF + cur * 64 * TS_; const LAS unsigned char* GT = F.lds + GT_OFF + cur * 64 * TS_;
        LAS unsigned char* YT = F.lds + YT_OFF + cur * 64 * TS_;
        f32x4 accA[4], accX[4];
#pragma unroll
        for (int rt = 0; rt < 4; ++rt) { accA[rt] = (f32x4){0.f, 0.f, 0.f, 0.f}; accX[rt] = (f32x4){0.f, 0.f, 0.f, 0.f};
#pragma unroll
            for (int kb = 0; kb < 4; ++kb) { const bf16x8 a = *(const LAS bf16x8*)(UB + (16 * rt + cl) * TS_ + (32 * kb + 8 * tq) * 2);
                accA[rt] = __builtin_amdgcn_mfma_f32_16x16x32_bf16(a, bfa[kb], accA[rt], 0, 0, 0);
                accX[rt] = __builtin_amdgcn_mfma_f32_16x16x32_bf16(a, bfx[kb], accX[rt], 0, 0, 0); } }
#pragma unroll
        for (int rt = 0; rt < 4; ++rt) {
            float av[4], bv[4], gv[4];
#pragma unroll
            for (int i = 0; i < 4; ++i) { const int tl = 16 * rt + 4 * tq + i;
                const float ra = pg8::fast_rcp(1.0f + pg8::fast_exp2(fmaf(accA[rt][i], -LOG2E, ba2))), ix = pg8::fast_rcp(1.0f + pg8::fast_exp2(fmaf(accX[rt][i], -LOG2E, bx2)));
                const float a = __builtin_amdgcn_exp2f(ra * LA2);
                const float mult = __builtin_amdgcn_sqrtf(fmaxf(fmaf(-a, a, 1.0f), 0.f));
                const float uf = bf2f(*(const LAS unsigned short*)(UB + tl * TS_ + 2 * chl));
                gv[i] = bf2f(*(const LAS unsigned short*)(GT + tl * TS_ + 2 * chl));
                av[i] = a; bv[i] = mult * ix * uf; }
            float A = av[0], B = bv[0];
#pragma unroll
            for (int i = 1; i < 4; ++i) { B = B * av[i] + bv[i]; A = A * av[i]; }
            float Ag[4], Bg[4];
#pragma unroll
            for (int j = 0; j < 4; ++j) { Ag[j] = __builtin_bit_cast(float, __builtin_amdgcn_ds_bpermute((cl + 16 * j) << 2, __builtin_bit_cast(int, A))); Bg[j] = __builtin_bit_cast(float, __builtin_amdgcn_ds_bpermute((cl + 16 * j) << 2, __builtin_bit_cast(int, B))); }
            float hin = hc, hend = hc;
#pragma unroll
            for (int j = 0; j < 4; ++j) { if (j < tq) hin = Ag[j] * hin + Bg[j]; hend = Ag[j] * hend + Bg[j]; }
            float hh = hin, yv_[4];
#pragma unroll
            for (int i = 0; i < 4; ++i) { const int t = sc + 16 * rt + 4 * tq + i;
                hh = av[i] * hh + bv[i];
                if (lastsc) hlast = (t == T - 1) ? hh : hlast;
                yv_[i] = hh * gv[i]; }
            { const unsigned p01 = pg8::cvt_pk_bf16(yv_[0], yv_[1]), p23 = pg8::cvt_pk_bf16(yv_[2], yv_[3]);
              LAS unsigned char* yp = YT + (16 * rt + 4 * tq) * TS_ + 2 * chl;
              *(LAS unsigned short*)(yp) = (unsigned short)(p01 & 0xffffu); *(LAS unsigned short*)(yp + TS_) = (unsigned short)(p01 >> 16);
              *(LAS unsigned short*)(yp + 2 * TS_) = (unsigned short)(p23 & 0xffffu); *(LAS unsigned short*)(yp + 3 * TS_) = (unsigned short)(p23 >> 16); }
            hc = hend;
        }
        if (more) LRU_CONVW(cur ^ 1, sc + 64);
        __syncthreads();
    }
    LRU_FLUSH((nsc - 1) & 1, 64 * (nsc - 1));
    { const int tl_last = (T - 1) - 64 * (nsc - 1); if ((tl_last >> 2 & 3) == tq) h_out[ch] = hlast; }
    __syncthreads();
#undef LRU_LOADX
#undef LRU_CONVW
#undef LRU_FLUSH
#undef LRU_X4
}

enum { SK_SWIGLU = 0, SK_RES = 1, SK_IN = 2, SK_OUT = 3 };
struct SkP {
    const bf16* A; int lda; const bf16* B; int ldb; int K; int ncg;
    const float* rs; const float* ssq_in;
    bf16* Hout;
    const float* base; bf16* xa; float* ssq_out; float coef;
    bf16* Q; bf16* Kb; bf16* Vb; bf16* GG; bf16* XL; float* out;
};
template <int KIND>
__device__ __forceinline__ void skinny_phase(Frame& F, const SkP& P, const float* sca = nullptr, const float* scl = nullptr) {
    int l = F.lane, tid = F.tid; asm volatile("" : "+v"(l), "+v"(tid));
    const int w = F.wave, lr = l & 15, lq = l >> 4;
    constexpr int NB = KIND == SK_SWIGLU ? 2 : 1;
    constexpr int CGN = (KIND == SK_SWIGLU || KIND == SK_IN) ? 3 : 1;
    constexpr int BSTEP = CGN == 3 ? 1 : 2, DEPTH = 3;
    constexpr int NBF = CGN * NB;
    LAS float* red = (LAS float*)F.lds;
    const int half_g = F.G >> 1, kw = P.K / 8, nbat = kw / (32 * BSTEP);
    const int rh = blockIdx.x & 1, cg0 = blockIdx.x >> 1;
    if (cg0 < P.ncg) {
        bool cgv[CGN]; const bf16* Bb[NBF];
#pragma unroll
        for (int j = 0; j < CGN; ++j) { const int cg = cg0 + j * half_g; cgv[j] = cg < P.ncg; const int c0 = 16 * (cgv[j] ? cg : cg0);
            int brow = c0 + lr; if (KIND == SK_SWIGLU) brow = 256 * (c0 >> 7) + (c0 & 127) + lr;
            Bb[j * NB] = P.B + (size_t)brow * P.ldb + w * kw + 8 * lq; if (NB == 2) Bb[j * NB + NB - 1] = Bb[j * NB] + (size_t)128 * P.ldb; }
        const bf16* Ab = P.A + (size_t)(64 * rh + lr) * P.lda + w * kw + 8 * lq;
        const size_t rstep = (size_t)16 * P.lda;
        pg8::f32x4 acc[4][NBF];
#pragma unroll
        for (int rt = 0; rt < 4; ++rt)
#pragma unroll
            for (int q = 0; q < NBF; ++q) acc[rt][q] = (pg8::f32x4){0.f, 0.f, 0.f, 0.f};
        bf16x8 ra[DEPTH][BSTEP][4], rb[DEPTH][BSTEP][NBF];
#define SK_LOAD(d_, b_) do { _Pragma("unroll") for (int u = 0; u < BSTEP; ++u) { const int k_ = ((b_) * BSTEP + u) * 32; \
            _Pragma("unroll") for (int rt = 0; rt < 4; ++rt) ra[d_][u][rt] = *(const bf16x8*)(Ab + rt * rstep + k_); \
            _Pragma("unroll") for (int q = 0; q < NBF; ++q) rb[d_][u][q] = *(const bf16x8*)(Bb[q] + k_); } } while (0)
#define SK_MMA(d_) do { _Pragma("unroll") for (int u = 0; u < BSTEP; ++u) _Pragma("unroll") for (int rt = 0; rt < 4; ++rt) _Pragma("unroll") for (int q = 0; q < NBF; ++q) \
            acc[rt][q] = __builtin_amdgcn_mfma_f32_16x16x32_bf16(rb[d_][u][q], ra[d_][u][rt], acc[rt][q], 0, 0, 0); } while (0)
        SK_LOAD(0, 0); if (1 < nbat) SK_LOAD(1, 1); if (2 < nbat) SK_LOAD(2, 2);
        for (int b = 0; b < nbat; b += 3) {
            SK_MMA(0); if (b + 3 < nbat) SK_LOAD(0, b + 3);
            if (b + 1 < nbat) { SK_MMA(1); if (b + 4 < nbat) SK_LOAD(1, b + 4); }
            if (b + 2 < nbat) { SK_MMA(2); if (b + 5 < nbat) SK_LOAD(2, b + 5); }
        }
#undef SK_LOAD
#undef SK_MMA
        if (KIND == SK_OUT) {
#pragma unroll
            for (int rt = 0; rt < 4; ++rt) { const int R = MP + 64 * rh + 16 * rt + lr; const float* sp = (w >= 4 ? scl : sca) + (size_t)R * 8;
                const pg8::f32x4 x = *(const pg8::f32x4*)sp, y = *(const pg8::f32x4*)(sp + 4);
                const float t = ((x[0] + x[1]) + (x[2] + x[3])) + ((y[0] + y[1]) + (y[2] + y[3])); acc[rt][0] = acc[rt][0] * (1.0f / sqrtf(t * (1.0f / AW) + RMS_EPS)); } }
#pragma unroll
        for (int j = 0; j < CGN; ++j) {
            if (!cgv[j]) continue;
            const int c0 = 16 * (cg0 + j * half_g);
#pragma unroll
            for (int rt = 0; rt < 4; ++rt)
#pragma unroll
                for (int nb = 0; nb < NB; ++nb) *(LAS pg8::f32x4*)(red + ((((nb * 8 + w) * 64) + 16 * rt + lr) * 4 + lq) * 4) = acc[rt][j * NB + nb];
            __syncthreads();
            if (tid < 256) {
                const int row = tid >> 2, qd = tid & 3, m = 64 * rh + row, R = MP + m, c = c0 + 4 * qd;
                pg8::f32x4 acc0 = {0.f, 0.f, 0.f, 0.f}, acc1 = {0.f, 0.f, 0.f, 0.f};
#pragma unroll
                for (int ww = 0; ww < 8; ++ww) { acc0 = acc0 + *(const LAS pg8::f32x4*)(red + (((ww * 64) + row) * 4 + qd) * 4); if (NB == 2) acc1 = acc1 + *(const LAS pg8::f32x4*)(red + ((((8 + ww) * 64) + row) * 4 + qd) * 4); }
                if (KIND == SK_SWIGLU) {
                    const float s = P.ssq_in ? 1.0f / sqrtf(P.ssq_in[R] * (1.0f / DM) + RMS_EPS) : P.rs[R];
                    float h[4];
#pragma unroll
                    for (int jj = 0; jj < 4; ++jj) h[jj] = pg8::silu_f(acc0[jj] * s) * (acc1[jj] * s);
                    v2u o; o.x = pg8::cvt_pk_bf16(h[0], h[1]); o.y = pg8::cvt_pk_bf16(h[2], h[3]);
                    *(v2u*)(P.Hout + (size_t)R * HLD + c) = o;
                } else if (KIND == SK_RES || KIND == SK_OUT) {
                    pg8::f32x4 b;
                    if (P.base) b = *(const pg8::f32x4*)(P.base + (size_t)m * DM + c);
                    else { const v2u wv = *(const v2u*)(P.xa + (size_t)R * DM + c);
                        b = (pg8::f32x4){__builtin_bit_cast(float, wv.x << 16), __builtin_bit_cast(float, wv.x & 0xffff0000u), __builtin_bit_cast(float, wv.y << 16), __builtin_bit_cast(float, wv.y & 0xffff0000u)}; }
                    const pg8::f32x4 x = b + acc0 * P.coef;
                    { v2u o; o.x = pg8::cvt_pk_bf16(x[0], x[1]); o.y = pg8::cvt_pk_bf16(x[2], x[3]); *(v2u*)(P.xa + (size_t)R * DM + c) = o;
                      float ss = (x[0] * x[0] + x[1] * x[1]) + (x[2] * x[2] + x[3] * x[3]); ss = sum_x1(ss); ss = sum_x2(ss);
                      if (qd == 0) __hip_atomic_fetch_add(P.ssq_out + R, ss, __ATOMIC_RELAXED, __HIP_MEMORY_SCOPE_AGENT); }
                } else {
                    const float s = 1.0f / sqrtf(P.ssq_in[R] * (1.0f / DM) + RMS_EPS);
                    pg8::f32x4 v = acc0 * s; const int seg = c0 >> 10, cs = (c0 & 1023) + 4 * qd;
                    v2u o; o.x = pg8::cvt_pk_bf16(v[0], v[1]); o.y = pg8::cvt_pk_bf16(v[2], v[3]);
                    if (seg == 0) { v2u oq; oq.x = pg8::cvt_pk_bf16(v[0] * ATT_C2, v[1] * ATT_C2); oq.y = pg8::cvt_pk_bf16(v[2] * ATT_C2, v[3] * ATT_C2); *(v2u*)(P.Q + (size_t)R * AW + cs) = oq; }
                    else if (seg == 1) { *(v2u*)(P.Kb + (size_t)R * AW + cs) = o; *(pg8::f32x4*)(P.out + OFF_KS + (size_t)m * AW + cs) = v; }
                    else if (seg == 2) { *(v2u*)(P.Vb + (size_t)R * AW + cs) = o; *(pg8::f32x4*)(P.out + OFF_VS + (size_t)m * AW + cs) = v; }
                    else if (seg == 3) *(v2u*)(P.XL + (size_t)R * AW + cs) = o;
                    else {
#pragma unroll
                        for (int jj = 0; jj < 4; ++jj) v[jj] = pg8::gelu_tanh_f(v[jj]);
                        o.x = pg8::cvt_pk_bf16(v[0], v[1]); o.y = pg8::cvt_pk_bf16(v[2], v[3]); *(v2u*)(P.GG + (size_t)R * AW + cs) = o; }
                }
            }
            __syncthreads();
        }
    }
}

constexpr int N_LAUNCHES = MK_N_LAUNCHES, N_PHASES = 9;
__global__ void __launch_bounds__(NWAVES * 64, 2) mega_fwd(Args args) {
    extern __shared__ __attribute__((aligned(16))) unsigned char lds[];
    Frame F;
    F.lds = (LAS unsigned char*)lds;
    F.MISC = (volatile LAS unsigned*)(F.lds + MISC_OFF);
    const int wave0 = __builtin_amdgcn_readfirstlane((int)threadIdx.x >> 6);
    F.wave = wave0; F.lane = (int)__builtin_amdgcn_mbcnt_hi(~0u, __builtin_amdgcn_mbcnt_lo(~0u, 0u)); F.tid = wave0 * 64 + F.lane;
    F.G = gridDim.x;
    unsigned char* ws = args.ws; F.ws = ws; F.out = args.out;
    F.ctl = (gu32*)(ws + WS_CTL);
    for (int u = F.tid; u < (LDS_BYTES - LDSCTL_OFF) / 4; u += NWAVES * 64) ((LAS unsigned*)(F.lds + LDSCTL_OFF))[u] = 0u;
    __syncthreads();
    XcdBarrier bar; bar.bar = (unsigned*)(F.ctl + CW_BAR); bar.x = 0; bar.st = nullptr;
    if (N_LAUNCHES == 1) bar = xcd_barrier_post((unsigned*)(F.ctl + CW_BAR), F.MISC + 8, F.tid == 0);
#define GRID_BAR() do { if (N_LAUNCHES == 1) { REFRESH_F(); xcd_barrier(bar, F.tid == 0); } } while (0)
    const int lo = args.ph_lo, hi = args.ph_hi;
#define REFRESH_F() do { unsigned z_ = 0u; asm volatile("" : "+v"(z_));   const int l_ = (int)__builtin_amdgcn_mbcnt_hi(~0u, __builtin_amdgcn_mbcnt_lo(~0u, z_)); F.lane = l_; F.wave = wave0; F.tid = wave0 * 64 + l_; } while (0)
#define IN(k) (lo <= (k) && (k) < hi)
#define BOTH(k) (IN(k) && IN((k) + 1))
    float* out = args.out;
    pg8::bf16_t* XA = (pg8::bf16_t*)(ws + WS_XA); pg8::bf16_t* Hb = (pg8::bf16_t*)(ws + WS_H); pg8::bf16_t* GRP = (pg8::bf16_t*)(ws + WS_GRP);

    if (IN(0)) { REFRESH_F(); p0_prologue(F, args); if (BOTH(0)) GRID_BAR(); }

    if (IN(1)) {
        REFRESH_F();
        pg8::Gemm g{XA, (const pg8::bf16_t*)(ws + WS_WGU1), MP, NGU, DM, DM, DM}; pg8::StaticOrder S; S.init(MP, NGU, F.G, (int)blockIdx.x);
        pg8::EpiSwiGLU<false> E{Hb, (const float*)(ws + WS_RS1)};
        pg8::gemm_phase<pg8::EpiSwiGLU<false>, pg8::StaticOrder, true, true>(F.lds, g, S, E, F.tid, F.wave);
        { SkP P{}; P.A = XA + (size_t)MP * DM; P.lda = DM; P.B = (const bf16*)(ws + WS_WGU1); P.ldb = DM; P.K = DM; P.ncg = DFF / 16; P.rs = (const float*)(ws + WS_RS1); P.Hout = Hb;
          skinny_phase<SK_SWIGLU>(F, P); }
        if (BOTH(1)) GRID_BAR();
    }
    if (IN(2)) {
        REFRESH_F();
        pg8::Gemm g{Hb, (const pg8::bf16_t*)(ws + WS_WD1), MP, DM, DFF, HLD, DFF}; pg8::StaticOrder S; S.init(MP, DM, F.G, (int)blockIdx.x, true, 4);
        pg8::EpiRes<0, false> E{nullptr, XA, (float*)(ws + WS_SSQ2), nullptr, 0.5f, nullptr};
        pg8::gemm_phase<pg8::EpiRes<0, false>, pg8::StaticOrder, true, true>(F.lds, g, S, E, F.tid, F.wave);
        { SkP P{}; P.A = Hb + (size_t)MP * HLD; P.lda = HLD; P.B = (const bf16*)(ws + WS_WD1); P.ldb = DFF; P.K = DFF; P.ncg = DM / 16;
          P.base = nullptr; P.xa = XA; P.ssq_out = (float*)(ws + WS_SSQ2); P.coef = 0.5f;
          skinny_phase<SK_RES>(F, P); }
        if (BOTH(2)) GRID_BAR();
    }
    if (IN(3)) {
        REFRESH_F();
        pg8::Gemm g{XA, (const pg8::bf16_t*)(ws + WS_WIN), MP, NIN, DM, DM, DM}; pg8::StaticOrder S; S.init(MP, NIN, F.G, (int)blockIdx.x);
        pg8::EpiIn E{(const float*)(ws + WS_SSQ2), (pg8::bf16_t*)(ws + WS_Q), (pg8::bf16_t*)(ws + WS_KB), (pg8::bf16_t*)(ws + WS_VB), (pg8::bf16_t*)(ws + WS_XL), (pg8::bf16_t*)(ws + WS_GG), out};
        pg8::gemm_phase<pg8::EpiIn, pg8::StaticOrder, true, true>(F.lds, g, S, E, F.tid, F.wave);
        { SkP P{}; P.A = XA + (size_t)MP * DM; P.lda = DM; P.B = (const bf16*)(ws + WS_WIN); P.ldb = DM; P.K = DM; P.ncg = NIN / 16; P.ssq_in = (const float*)(ws + WS_SSQ2);
          P.Q = (bf16*)(ws + WS_Q); P.Kb = (bf16*)(ws + WS_KB); P.Vb = (bf16*)(ws + WS_VB); P.GG = (bf16*)(ws + WS_GG); P.XL = (bf16*)(ws + WS_XL); P.out = out;
          skinny_phase<SK_IN>(F, P); }
        if (BOTH(3)) GRID_BAR();
    }
    if (IN(4)) {
        REFRESH_F();
        const int c = (int)blockIdx.x;
        const int nr = F.G - 128;
        for (int k = 0;; ++k) {
            int rowbase, T, n; const float* prefix; const float* h0; float* co; float* ho;
            if (c < 128) { if (k > 0) break; const int b = c >> 3; n = c & 7; rowbase = b * SP; T = SP; prefix = nullptr; h0 = nullptr; co = out + OFF_CP + (size_t)b * 3 * AW; ho = out + OFF_HP + (size_t)b * AW; }
            else { const int u = c - 128 + k * nr; if (u >= BS * 8) break; const int b = u >> 3; n = u & 7; rowbase = MP + TS * b; T = TS; prefix = args.in[4] + (size_t)b * 3 * AW; h0 = args.in[5] + (size_t)b * AW;
                   co = out + OFF_CS + (size_t)b * 3 * AW; ho = out + OFF_HS + (size_t)b * AW; }
            lru_unit(F, args, rowbase, T, n, prefix, h0, co, ho);
        }
        if (c >= 128) for (int u = c - 128; u < BS * NH; u += nr) sattn_unit(F, args, u >> 3, u & 7);
        { if (F.tid == 0) F.MISC[0] = __hip_atomic_fetch_add((unsigned*)(F.ctl + CW_QUEUE), 1u, RLX_AGENT);
          __syncthreads();
          unsigned u = F.MISC[0];
          __syncthreads();
          while (u < (unsigned)(BP * NH * 8)) {
            unsigned nxt = 0u;
            if (F.tid == 0) nxt = __hip_atomic_fetch_add((unsigned*)(F.ctl + CW_QUEUE), 1u, RLX_AGENT);
            const int qb = 7 - (int)(u >> 7), bh = (int)(u & 127);
            attn_unit(F, bh >> 3, bh & 7, qb);
            if (F.tid == 0) F.MISC[0] = nxt;
            __syncthreads();
            u = F.MISC[0];
            __syncthreads();
          } }
        if (BOTH(4)) GRID_BAR();
    }
    if (IN(5)) {
        REFRESH_F();
        pg8::StaticOrder S; S.init(MP, DM, F.G, (int)blockIdx.x, false, 4);
        LAS float* sct = (LAS float*)(F.lds + SCT_OFF);
        { pg8::Unit uu; for (int i = 0; i < 4 && S.next(i, uu); ++i) if (F.tid < 256) { const int row = uu.pm * 256 + F.tid;
              const f32x4 a0 = *(const f32x4*)((const float*)(ws + WS_SSQA) + (size_t)row * 8), a1 = *(const f32x4*)((const float*)(ws + WS_SSQA) + (size_t)row * 8 + 4);
              const f32x4 l0 = *(const f32x4*)((const float*)(ws + WS_SSQL) + (size_t)row * 8), l1 = *(const f32x4*)((const float*)(ws + WS_SSQL) + (size_t)row * 8 + 4);
              const float ta = ((a0[0] + a0[1]) + (a0[2] + a0[3])) + ((a1[0] + a1[1]) + (a1[2] + a1[3])), tl = ((l0[0] + l0[1]) + (l0[2] + l0[3])) + ((l1[0] + l1[1]) + (l1[2] + l1[3]));
              const float sa = 1.0f / sqrtf(ta * (1.0f / AW) + RMS_EPS), sl = 1.0f / sqrtf(tl * (1.0f / AW) + RMS_EPS); sct[(i * 256 + F.tid) * 2 + 0] = sa / sl; sct[(i * 256 + F.tid) * 2 + 1] = sl; }
          __syncthreads(); }
        { pg8::Gemm g{GRP, (const pg8::bf16_t*)(ws + WS_WOUT), MP, DM, DM, DM, DM};
          pg8::EpiRes<2, false> E{nullptr, XA, (float*)(ws + WS_SSQ3), sct, 1.0f, nullptr};
          pg8::gemm_phase<pg8::EpiRes<2, false>, pg8::StaticOrder, true, true, true>(F.lds, g, S, E, F.tid, F.wave); }
        { SkP P{}; P.A = GRP + (size_t)MP * DM; P.lda = DM; P.B = (const bf16*)(ws + WS_WOUT); P.ldb = DM; P.K = DM; P.ncg = DM / 16;
          P.base = nullptr; P.xa = XA; P.ssq_out = (float*)(ws + WS_SSQ3); P.coef = 1.0f;
          skinny_phase<SK_OUT>(F, P, (const float*)(ws + WS_SSQA), (const float*)(ws + WS_SSQL)); }
        if (BOTH(5)) GRID_BAR();
    }
    if (IN(6)) {
        REFRESH_F();
        pg8::Gemm g{XA, (const pg8::bf16_t*)(ws + WS_WGU2), MP, NGU, DM, DM, DM}; pg8::StaticOrder S; S.init(MP, NGU, F.G, (int)blockIdx.x);
        pg8::EpiSwiGLU<true> E{Hb, (const float*)(ws + WS_SSQ3)};
        pg8::gemm_phase<pg8::EpiSwiGLU<true>, pg8::StaticOrder, true, true>(F.lds, g, S, E, F.tid, F.wave);
        { SkP P{}; P.A = XA + (size_t)MP * DM; P.lda = DM; P.B = (const bf16*)(ws + WS_WGU2); P.ldb = DM; P.K = DM; P.ncg = DFF / 16; P.ssq_in = (const float*)(ws + WS_SSQ3); P.Hout = Hb;
          skinny_phase<SK_SWIGLU>(F, P); }
        if (BOTH(6)) GRID_BAR();
    }
    if (IN(7)) {
        REFRESH_F();
        pg8::Gemm g{Hb, (const pg8::bf16_t*)(ws + WS_WD2), MP, DM, DFF, HLD, DFF}; pg8::StaticOrder S; S.init(MP, DM, F.G, (int)blockIdx.x, true, 4);
        pg8::EpiRes<0, false> E{nullptr, XA, (float*)(ws + WS_SSQ4), nullptr, 0.5f, nullptr};
        pg8::gemm_phase<pg8::EpiRes<0, false>, pg8::StaticOrder, true, true>(F.lds, g, S, E, F.tid, F.wave);
        { SkP P{}; P.A = Hb + (size_t)MP * HLD; P.lda = HLD; P.B = (const bf16*)(ws + WS_WD2); P.ldb = DFF; P.K = DFF; P.ncg = DM / 16;
          P.base = nullptr; P.xa = XA; P.ssq_out = (float*)(ws + WS_SSQ4); P.coef = 0.5f;
          skinny_phase<SK_RES>(F, P); }
        if (BOTH(7)) GRID_BAR();
    }
    if (IN(8)) {
        REFRESH_F();
        const int gw = blockIdx.x * NWAVES + F.wave, NGW = F.G * NWAVES;
        f32x4 gfv[8];
        { const GAS f32x4* gf = (const GAS f32x4*)args.in[27] + 2 * F.lane;
#pragma unroll
          for (int j = 0; j < 4; ++j) { gfv[2 * j] = gf[128 * j]; gfv[2 * j + 1] = gf[128 * j + 1]; } }
        const float* ssq4 = (const float*)(ws + WS_SSQ4);
        for (int m0 = gw; m0 < MP + MS; m0 += 2 * NGW) {
            v4u v[2][4]; float rsv[2];
#pragma unroll
            for (int q = 0; q < 2; ++q) { const int m = m0 + q * NGW; if (m < MP + MS) {
                const GAS v4u* xr = (const GAS v4u*)(XA + (size_t)m * DM) + F.lane;
#pragma unroll
                for (int j = 0; j < 4; ++j) v[q][j] = xr[64 * j];
                rsv[q] = ssq4[m]; } }
#pragma unroll
            for (int q = 0; q < 2; ++q) { const int m = m0 + q * NGW; if (m < MP + MS) {
                float* rowp = m < MP ? out + OFF_YP + (size_t)m * DM : out + OFF_YS + (size_t)(m - MP) * DM;
                GAS f32x4* xw = (GAS f32x4*)rowp + 2 * F.lane;
                const float rs = 1.0f / sqrtf(rsv[q] * (1.0f / DM) + RMS_EPS);
#pragma unroll
                for (int j = 0; j < 4; ++j) { const v4u w = v[q][j];
                    const f32x4 a = {__builtin_bit_cast(float, w.x << 16), __builtin_bit_cast(float, w.x & 0xffff0000u), __builtin_bit_cast(float, w.y << 16), __builtin_bit_cast(float, w.y & 0xffff0000u)};
                    const f32x4 b = {__builtin_bit_cast(float, w.z << 16), __builtin_bit_cast(float, w.z & 0xffff0000u), __builtin_bit_cast(float, w.w << 16), __builtin_bit_cast(float, w.w & 0xffff0000u)};
                    xw[128 * j] = a * rs * gfv[2 * j]; xw[128 * j + 1] = b * rs * gfv[2 * j + 1]; } } }
        }
    }
#undef IN
#undef BOTH
#undef GRID_BAR
}

extern "C" void kernel_launch(void* const* d_in, const int* in_sizes, int n_in, void* d_out, int out_size, void* d_ws, size_t ws_size, hipStream_t stream) {
    static int grid = 0;
    if (grid == 0) {
        if (n_in != 28 || in_sizes[0] != MP * DM || (size_t)out_size != OUT_TOTAL || ws_size < WS_END) {
            fprintf(stderr, "kernel_launch: unexpected shapes (n_in %d, in0 %d, out %d, ws %zu); nothing launched\n", n_in, n_in > 0 ? in_sizes[0] : -1, out_size, ws_size); grid = -1; return; }
        int dev = 0, cus = 0, per_cu = 0;
        if (hipGetDevice(&dev) != hipSuccess || hipDeviceGetAttribute(&cus, hipDeviceAttributeMultiprocessorCount, dev) != hipSuccess) { grid = -1; return; }
        if (hipFuncSetAttribute((const void*)mega_fwd, hipFuncAttributeMaxDynamicSharedMemorySize, LDS_BYTES) != hipSuccess) { fprintf(stderr, "kernel_launch: hipFuncSetAttribute failed\n"); grid = -1; return; }
        if (hipOccupancyMaxActiveBlocksPerMultiprocessor(&per_cu, (const void*)mega_fwd, NWAVES * 64, LDS_BYTES) != hipSuccess || per_cu < 1)
            fprintf(stderr, "kernel_launch: occupancy query reports %d workgroups per CU\n", per_cu);
        (void)hipGetLastError();
        grid = cus;
        if (grid < 129) { fprintf(stderr, "kernel_launch: needs >= 129 CUs\n"); grid = -1; return; }
    }
    if (grid < 0) return;
    (void)hipMemsetAsync((char*)d_ws + WS_CTL, 0, CTL_ZERO_BYTES, stream);
    Args a{};
    for (int i = 0; i < 28; ++i) a.in[i] = (const float*)d_in[i];
    a.out = (float*)d_out; a.ws = (unsigned char*)d_ws;
    if (N_LAUNCHES == 1) { a.ph_lo = 0; a.ph_hi = N_PHASES; hipLaunchKernelGGL(mega_fwd, dim3(grid), dim3(NWAVES * 64), LDS_BYTES, stream, a); }
    else for (int li = 0; li < N_PHASES; ++li) { a.ph_lo = li; a.ph_hi = li + 1; hipLaunchKernelGGL(mega_fwd, dim3(grid), dim3(NWAVES * 64), LDS_BYTES, stream, a); }
}
```

```cpp
#include <hip/hip_runtime.h>
#include <cstdio>
#include <cstdint>

#ifndef MK_N_LAUNCHES
#define MK_N_LAUNCHES 1
#endif

#define LAS __attribute__((address_space(3)))
#define GAS __attribute__((address_space(1)))

constexpr int DM = 2048, BP = 16, SP = 2048, MP = BP * SP  , BS = 32, TS = 4, MS = BS * TS  ;
constexpr int MPAD = MP + 256  , NMT = MPAD / 256  ;
constexpr int DFF = 5632, HLD = DFF + 64  , NGU = 2 * DFF, NIN = 5120, AW = 1024, NH = 8, HD = 128;
constexpr float RMS_EPS = 1e-6f;
constexpr float LOG2E = 1.4426950408889634f;
constexpr float ATT_C2 = 0.08838834764831845f * 1.4426950408889634f;
constexpr int TBN = 2432;

constexpr size_t OFF_YP = 0, OFF_YS = 67108864, OFF_KP = 67371008, OFF_VP = 100925440, OFF_CP = 134479872, OFF_HP = 134529024,
                 OFF_KS = 134545408, OFF_VS = 134676480, OFF_CS = 134807552, OFF_HS = 134905856, OUT_TOTAL = 134938624;

constexpr size_t MiB = 1u << 20;
constexpr size_t WS_CTL = 0, CTL_ZERO_BYTES = 64 * 1024;
constexpr size_t WS_RS1 = 1 * MiB, WS_SSQ2 = WS_RS1 + 256 * 1024, WS_SSQ3 = WS_RS1 + 512 * 1024, WS_SSQ4 = WS_RS1 + 768 * 1024;
constexpr size_t WS_TBL = 2 * MiB, WS_WAX = 3 * MiB, WS_SSQA = 4 * MiB, WS_SSQL = 6 * MiB;
constexpr size_t WS_WGU1 = 8 * MiB, WS_WD1 = 52 * MiB, WS_WIN = 74 * MiB, WS_WOUT = 94 * MiB, WS_WGU2 = 102 * MiB, WS_WD2 = 146 * MiB;
constexpr size_t WS_XA = 168 * MiB, WS_GRP = 297 * MiB, WS_GG = 426 * MiB, WS_H = 491 * MiB;
constexpr size_t WS_Q = WS_H, WS_KB = WS_H + 65 * MiB, WS_VB = WS_H + 130 * MiB, WS_XL = WS_H + 195 * MiB;
constexpr size_t WS_END = 852 * MiB;
static_assert((size_t)MPAD * DM * 2 <= 129 * MiB && (size_t)MPAD * HLD * 2 <= 361 * MiB && (size_t)MPAD * AW * 2 <= 65 * MiB && (size_t)MPAD * AW * 4 <= 129 * MiB, "ws map");
static_assert(WS_XL + (size_t)MPAD * AW * 4 <= WS_END && (size_t)MPAD * 8 * 4 <= 2 * MiB && (size_t)MPAD * 4 <= 256 * 1024, "ws map 2");
constexpr int CW_TMO = 0, CW_CODE = 1, CW_QUEUE = 64, CW_BAR = 4096;

constexpr int RING_BYTES = 131072, LDSCTL_OFF = RING_BYTES, MISC_OFF = LDSCTL_OFF + 320, LDS_BYTES = 147456;
constexpr int RV_OFF = LDSCTL_OFF + 512  , SCT_OFF = RV_OFF + 2048  ;
static_assert(SCT_OFF + 4 * 256 * 2 * 4 <= LDS_BYTES, "lds map");


template <int CTRL> __device__ __forceinline__ float dppf(float v) { return __builtin_bit_cast(float, __builtin_amdgcn_update_dpp(0, __builtin_bit_cast(int, v), CTRL, 0xF, 0xF, true)); }
__device__ __forceinline__ float sum_x1(float v) { return v + dppf<0xB1>(v); }
__device__ __forceinline__ float sum_x2(float v) { return v + dppf<0x4E>(v); }
__device__ __forceinline__ float sum16(float v) { v = sum_x1(v); v = sum_x2(v); v += dppf<0x141>(v); v += dppf<0x140>(v); return v; }
__device__ __forceinline__ float sum_r16(float v) { auto r = __builtin_amdgcn_permlane16_swap(__builtin_bit_cast(unsigned, v), __builtin_bit_cast(unsigned, v), false, false);
    return __builtin_bit_cast(float, (unsigned)r[0]) + __builtin_bit_cast(float, (unsigned)r[1]); }
__device__ __forceinline__ float sum_r32(float v) { auto r = __builtin_amdgcn_permlane32_swap(__builtin_bit_cast(unsigned, v), __builtin_bit_cast(unsigned, v), false, false);
    return __builtin_bit_cast(float, (unsigned)r[0]) + __builtin_bit_cast(float, (unsigned)r[1]); }

namespace pg8 {
#define PG8_LAS __attribute__((address_space(3)))
typedef unsigned short bf16_t;
typedef short bf16x8 __attribute__((ext_vector_type(8)));
typedef float f32x4 __attribute__((ext_vector_type(4)));
typedef unsigned u32x4 __attribute__((ext_vector_type(4)));
typedef unsigned u32x2 __attribute__((ext_vector_type(2)));
constexpr int BM = 256, BK = 64, HALF = 128, HTB = HALF * BK * 2, STAGE_BYTES = 8 * HTB, NXCD = 8, WGM = 8;

__host__ __device__ __forceinline__ int lds_byte(int r, int c) { const int st = (r >> 4) * 2 + (c >> 5), rr = r & 15, cc = c & 31, ob = rr * 64 + cc * 2; return st * 1024 + (ob ^ (((ob >> 9) & 1) << 5)); }
__host__ __device__ __forceinline__ void stage_rc(int b, int& R, int& C) { const int st = b / 1024, sb = b % 1024, swz = sb ^ (((sb >> 9) & 1) << 5); R = (st >> 1) * 16 + swz / 64; C = (st & 1) * 32 + (swz % 64) / 2; }
__host__ __device__ __forceinline__ int perm32(int rho) { const int n = rho >> 4, i = rho & 15; return 8 * (i >> 2) + 4 * n + (i & 3); }

struct Unit { int pm, pn; };
struct Gemm { const bf16_t* A; const bf16_t* Bt; int M, N, K, lda, ldb; };

struct StaticOrder {
    int nM, nN, nwg, G, c, R, wgm;
    __host__ __device__ __forceinline__ void init(int M, int N, int G_, int c_, bool rev = false, int wgm_ = WGM) { nM = M / BM; nN = N / BM; nwg = nM * nN; G = G_; c = c_; R = rev ? (nwg + G_ - 1) / G_ : 0; wgm = wgm_; }
    __host__ __device__ __forceinline__ bool next(int i, Unit& u) const {
        if (R > 0 && i >= R) return false;
        const long L = (long)(R > 0 ? R - 1 - i : i) * G + c; if (L >= nwg) return false;
        int wgid = (int)L; { const int q = nwg / NXCD, r = nwg % NXCD, xcd = wgid % NXCD, off = wgid / NXCD; wgid = (xcd < r ? xcd * (q + 1) : r * (q + 1) + (xcd - r) * q) + off; }
        const int nig = wgm * nN, gid = wgid / nig, fm = gid * wgm, gsz = (nM - fm) < wgm ? (nM - fm) : wgm;
        u.pm = fm + ((wgid % nig) % gsz); u.pn = (wgid % nig) / gsz; return true;
    }
    __device__ __forceinline__ void a_ready(const Unit&) const {}
    __device__ __forceinline__ void done(const Unit&) const {}
};

__device__ __forceinline__ unsigned cvt_pk_bf16(float lo, float hi) { unsigned r; asm volatile("v_cvt_pk_bf16_f32 %0, %1, %2" : "=v"(r) : "v"(lo), "v"(hi)); return r; }
__device__ __forceinline__ u32x4 pack8(const f32x4 a, const f32x4 b) { u32x4 w; w.x = cvt_pk_bf16(a[0], a[1]); w.y = cvt_pk_bf16(a[2], a[3]); w.z = cvt_pk_bf16(b[0], b[1]); w.w = cvt_pk_bf16(b[2], b[3]); return w; }
__device__ __forceinline__ float fast_rcp(float x) { return __builtin_amdgcn_rcpf(x); }
__device__ __forceinline__ float fast_exp2(float x) { return __builtin_amdgcn_exp2f(x); }
__device__ __forceinline__ float silu_f(float x) { return x * fast_rcp(1.0f + fast_exp2(-x * 1.4426950408889634f)); }
__device__ __forceinline__ float sigmoid_f(float x) { return fast_rcp(1.0f + fast_exp2(-x * 1.4426950408889634f)); }
__device__ __forceinline__ float gelu_tanh_f(float x) { const float z = 0.7978845608028654f * (x + 0.044715f * x * x * x); return x * fast_rcp(1.0f + fast_exp2(-2.0f * 1.4426950408889634f * z)); }


template <bool FROM_SSQ> struct EpiSwiGLU {
    static constexpr bool PERM = true, AFTER_DRAIN = false; static constexpr int ROWVEC = 1;
    bf16_t* Hout; const float* rowvec;
    __device__ __forceinline__ void operator()(const f32x4 (&acc)[2][2][4][2], const Unit& u, int ui, const PG8_LAS float* rv, int wr, int wc, int fr_in, int fq_in) const {
        int fr = fr_in, fq = fq_in; asm volatile("" : "+v"(fr), "+v"(fq));
        const int rl0 = wr * 64 + fr, row0 = u.pm * BM + rl0, colh = u.pn * 128 + wc * 32 + 8 * fq;
#pragma unroll
        for (int ai = 0; ai < 2; ++ai) {
#pragma unroll
            for (int m = 0; m < 4; ++m) {
                const int row = row0 + ai * HALF + m * 16;
                const float rvv = rv[rl0 + ai * HALF + m * 16];
                const float s = FROM_SSQ ? 1.0f / sqrtf(rvv * (1.0f / DM) + RMS_EPS) : rvv;
                f32x4 h0, h1;
                const float s2 = s * s, sn = s * -1.4426950408889634f;
#pragma unroll
                for (int j = 0; j < 4; ++j) { h0[j] = (acc[ai][0][m][0][j] * acc[ai][1][m][0][j]) * s2 * fast_rcp(1.0f + fast_exp2(acc[ai][0][m][0][j] * sn));
                                              h1[j] = (acc[ai][0][m][1][j] * acc[ai][1][m][1][j]) * s2 * fast_rcp(1.0f + fast_exp2(acc[ai][0][m][1][j] * sn)); }
                *(u32x4*)(Hout + (size_t)row * HLD + colh) = pack8(h0, h1);
            }
        }
    }
};

template <int SC, bool BASE_F32>
struct EpiRes {
    static constexpr bool PERM = true, AFTER_DRAIN = false; static constexpr int ROWVEC = 0;
    const float* baseP; bf16_t* xa; float* ssq; const PG8_LAS float* sct; float coef; const float* rowvec;
    __device__ __forceinline__ void midk(f32x4 (&acc)[2][2][4][2], int ui, int wr, int fr_in) const {
        int fr = fr_in; asm volatile("" : "+v"(fr));
#pragma unroll
        for (int ai = 0; ai < 2; ++ai)
#pragma unroll
            for (int m = 0; m < 4; ++m) { const float r = sct[(ui * 256 + wr * 64 + fr + ai * HALF + m * 16) * 2];
#pragma unroll
                for (int bj = 0; bj < 2; ++bj)
#pragma unroll
                    for (int n = 0; n < 2; ++n) acc[ai][bj][m][n] = acc[ai][bj][m][n] * r; }
    }
    __device__ __forceinline__ void operator()(const f32x4 (&acc)[2][2][4][2], const Unit& u, int ui, const PG8_LAS float* rv, int wr, int wc, int fr_in, int fq_in) const {
        int fr = fr_in, fq = fq_in; asm volatile("" : "+v"(fr), "+v"(fq));
        const int rl0 = wr * 64 + fr, row0 = u.pm * BM + rl0, col0 = u.pn * BM + wc * 32 + 8 * fq;
#pragma unroll
        for (int ai = 0; ai < 2; ++ai) {
            f32x4 bb[4][2][2];
#pragma unroll
            for (int m = 0; m < 4; ++m)
#pragma unroll
                for (int bj = 0; bj < 2; ++bj) { const size_t off = (size_t)(row0 + ai * HALF + m * 16) * DM + col0 + bj * HALF;
                    if (BASE_F32) { bb[m][bj][0] = *(const f32x4*)(baseP + off); bb[m][bj][1] = *(const f32x4*)(baseP + off + 4); }
                    else { const u32x4 w = *(const u32x4*)(xa + off);
                        bb[m][bj][0] = (f32x4){__builtin_bit_cast(float, w.x << 16), __builtin_bit_cast(float, w.x & 0xffff0000u), __builtin_bit_cast(float, w.y << 16), __builtin_bit_cast(float, w.y & 0xffff0000u)};
                        bb[m][bj][1] = (f32x4){__builtin_bit_cast(float, w.z << 16), __builtin_bit_cast(float, w.z & 0xffff0000u), __builtin_bit_cast(float, w.w << 16), __builtin_bit_cast(float, w.w & 0xffff0000u)}; } }
            asm volatile("" ::: "memory");
#pragma unroll
            for (int m = 0; m < 4; ++m) {
                const int row = row0 + ai * HALF + m * 16;
                float sc = coef;
                if (SC) sc = coef * sct[(ui * 256 + rl0 + ai * HALF + m * 16) * 2 + (SC - 1)];
                float ss = 0.f;
#pragma unroll
                for (int bj = 0; bj < 2; ++bj) {
                    const int c = col0 + bj * HALF;
                    const f32x4 x0 = bb[m][bj][0] + acc[ai][bj][m][0] * sc, x1 = bb[m][bj][1] + acc[ai][bj][m][1] * sc;
                    *(u32x4*)(xa + (size_t)row * DM + c) = pack8(x0, x1);
                    ss += ((x0[0] * x0[0] + x0[1] * x0[1]) + (x0[2] * x0[2] + x0[3] * x0[3])) + ((x1[0] * x1[0] + x1[1] * x1[1]) + (x1[2] * x1[2] + x1[3] * x1[3]));
                }
                ss = sum_r16(ss); ss = sum_r32(ss);
                if (fq == 0) __hip_atomic_fetch_add(ssq + row, ss, __ATOMIC_RELAXED, __HIP_MEMORY_SCOPE_AGENT);
            }
            asm volatile("" ::: "memory");
        }
    }
};

struct EpiIn {
    static constexpr bool PERM = true, AFTER_DRAIN = false; static constexpr int ROWVEC = 1;
    const float* rowvec; bf16_t* Q; bf16_t* Kb; bf16_t* Vb; bf16_t* XL; bf16_t* GG; float* out;
    __device__ __forceinline__ void operator()(const f32x4 (&acc)[2][2][4][2], const Unit& u, int ui, const PG8_LAS float* rv, int wr, int wc, int fr_in, int fq_in) const {
        int fr = fr_in, fq = fq_in; asm volatile("" : "+v"(fr), "+v"(fq));
        const int rl0 = wr * 64 + fr, row0 = u.pm * BM + rl0, seg = u.pn >> 2, cs0 = (u.pn & 3) * BM + wc * 32 + 8 * fq;
#pragma unroll
        for (int ai = 0; ai < 2; ++ai) {
#pragma unroll
            for (int m = 0; m < 4; ++m) {
                const int row = row0 + ai * HALF + m * 16;
                const float s = 1.0f / sqrtf(rv[rl0 + ai * HALF + m * 16] * (1.0f / DM) + RMS_EPS);
#pragma unroll
                for (int bj = 0; bj < 2; ++bj) {
                    const int cs = cs0 + bj * HALF;
                    f32x4 v0 = acc[ai][bj][m][0] * s, v1 = acc[ai][bj][m][1] * s;
                    if (seg == 0) { *(u32x4*)(Q + (size_t)row * AW + cs) = pack8(v0 * ATT_C2, v1 * ATT_C2); }
                    else if (seg == 1 || seg == 2) {
                        bf16_t* bb = seg == 1 ? Kb : Vb; *(u32x4*)(bb + (size_t)row * AW + cs) = pack8(v0, v1);
                        float* o = out + (seg == 1 ? OFF_KP : OFF_VP) + (size_t)row * AW + cs;
                        *(f32x4*)o = v0; *(f32x4*)(o + 4) = v1; }
                    else if (seg == 3) { *(u32x4*)(XL + (size_t)row * AW + cs) = pack8(v0, v1); }
                    else {
#pragma unroll
                        for (int j = 0; j < 4; ++j) { v0[j] = gelu_tanh_f(v0[j]); v1[j] = gelu_tanh_f(v1[j]); }
                        *(u32x4*)(GG + (size_t)row * AW + cs) = pack8(v0, v1); }
                }
            }
        }
    }
};

template <class Epi, class Sched, bool ALIGN_EPI = false, bool SP2 = false, bool MIDK = false>
__device__ __forceinline__ void gemm_phase(PG8_LAS unsigned char* lds, const Gemm g, const Sched& S, const Epi& E, const int tid, const int wid) {
    const int lane = tid & 63, wr = wid >> 2, wc = wid & 3, fr = lane & 15, fq = lane >> 4;
    const int K = g.K, nt = K / BK;
    unsigned voffA[2], voffB[2];
#pragma unroll
    for (int i = 0; i < 2; ++i) { int R, C; stage_rc(tid * 16 + i * 8192, R, C); const int Rb = Epi::PERM ? ((R & ~31) + perm32(R & 31)) : R;
        voffA[i] = (unsigned)(R * g.lda + C) * 2u; voffB[i] = (unsigned)(Rb * g.ldb + C) * 2u; }
    const size_t kstep = (size_t)(BK * 2);
    const size_t hstepA = (size_t)HALF * g.lda * 2, hstepB = (size_t)HALF * g.ldb * 2;
    const size_t tstepA = 2 * hstepA, tstepB = 2 * hstepB;
    const unsigned ldsw = (unsigned)wid * 1024u;
    const int aoff = lds_byte(wr * 64 + fr, fq * 8), boff = lds_byte(wc * 32 + fr, fq * 8);
#define PG8_SA(b, h) (((b) * 2 + (h)) * HTB)
#define PG8_SB(b, h) ((4 + (b) * 2 + (h)) * HTB)
#define PG8_STAGE(bufoff, gbase, voff) do { _Pragma("unroll") for (int _i = 0; _i < 2; ++_i) \
        __builtin_amdgcn_global_load_lds((const unsigned*)((const char*)(gbase) + (voff)[_i]), (PG8_LAS unsigned*)(lds + (bufoff) + ldsw + _i * 8192), 16, 0, 0); } while (0)
#define PG8_LDA(dst, b, h) do { _Pragma("unroll") for (int m = 0; m < 4; ++m) _Pragma("unroll") for (int k = 0; k < 2; ++k) dst[m][k] = *(const PG8_LAS bf16x8*)(lds + PG8_SA(b, h) + aoff + m * 2048 + k * 1024); } while (0)
#define PG8_LDB(dst, b, h) do { _Pragma("unroll") for (int n = 0; n < 2; ++n) _Pragma("unroll") for (int k = 0; k < 2; ++k) dst[n][k] = *(const PG8_LAS bf16x8*)(lds + PG8_SB(b, h) + boff + n * 2048 + k * 1024); } while (0)
#define PG8_MMA(ai, bj, At, Bt) do { __builtin_amdgcn_s_setprio(1); _Pragma("unroll") for (int m = 0; m < 4; ++m) _Pragma("unroll") for (int n = 0; n < 2; ++n) _Pragma("unroll") for (int k = 0; k < 2; ++k) \
        acc[ai][bj][m][n] = __builtin_amdgcn_mfma_f32_16x16x32_bf16(Bt[n][k], At[m][k], acc[ai][bj][m][n], 0, 0, 0); __builtin_amdgcn_s_setprio(0); } while (0)
#define PG8_WAIT_V(n) asm volatile("s_waitcnt vmcnt(" #n ")" ::: "memory")
#define PG8_WAIT_L(n) asm volatile("s_waitcnt lgkmcnt(" #n ")" ::: "memory")
#define PG8_BAR __builtin_amdgcn_s_barrier()
#define PG8_SCHED __builtin_amdgcn_sched_barrier(0)
    Unit cur, nxt; int ui = 0;
    if (!S.next(0, cur)) return;
    f32x4 acc[2][2][4][2];
#pragma unroll
    for (int a = 0; a < 2; ++a)
#pragma unroll
        for (int b = 0; b < 2; ++b)
#pragma unroll
            for (int m = 0; m < 4; ++m)
#pragma unroll
                for (int n = 0; n < 2; ++n) acc[a][b][m][n] = (f32x4){0.f, 0.f, 0.f, 0.f};
    bf16x8 At[4][2], B0[2][2], B1[2][2];
    const char* cA = (const char*)g.A + (size_t)cur.pm * tstepA; const char* cB = (const char*)g.Bt + (size_t)cur.pn * tstepB;
    S.a_ready(cur);
    if constexpr (SP2) {
        PG8_STAGE(PG8_SB(0, 0), cB, voffB); PG8_STAGE(PG8_SB(0, 1), cB + hstepB, voffB); PG8_STAGE(PG8_SA(0, 0), cA, voffA); PG8_STAGE(PG8_SA(0, 1), cA + hstepA, voffA);
        if (wr == 1) PG8_BAR;
        PG8_WAIT_V(2); PG8_BAR;
        PG8_STAGE(PG8_SB(1, 0), cB + kstep, voffB); PG8_STAGE(PG8_SA(1, 0), cA + kstep, voffA); PG8_STAGE(PG8_SB(1, 1), cB + hstepB + kstep, voffB);
        PG8_WAIT_V(6); PG8_BAR;
    } else {
        PG8_STAGE(PG8_SB(0, 0), cB, voffB); PG8_STAGE(PG8_SA(0, 0), cA, voffA); PG8_STAGE(PG8_SB(0, 1), cB + hstepB, voffB); PG8_STAGE(PG8_SA(0, 1), cA + hstepA, voffA);
        if (wr == 1) PG8_BAR;
        PG8_WAIT_V(4); PG8_BAR;
        PG8_STAGE(PG8_SB(1, 0), cB + kstep, voffB); PG8_STAGE(PG8_SA(1, 0), cA + kstep, voffA); PG8_STAGE(PG8_SB(1, 1), cB + hstepB + kstep, voffB);
        PG8_WAIT_V(6); PG8_BAR;
    }
    for (;;) {
        const bool has_next = S.next(ui + 1, nxt);
        const char* nA = has_next ? (const char*)g.A + (size_t)nxt.pm * tstepA : cA; const char* nB = has_next ? (const char*)g.Bt + (size_t)nxt.pn * tstepB : cB;
        if constexpr (Epi::ROWVEC != 0) { if (wid < 4) {
            int ln = fr | (fq << 4); asm volatile("" : "+v"(ln));
            __builtin_amdgcn_global_load_lds((const unsigned*)(E.rowvec + (size_t)cur.pm * BM + wid * 64 + ln), (PG8_LAS unsigned*)(lds + RV_OFF + (ui & 1) * 1024 + wid * 256), 4, 0, 0); } }
        for (int hseg = 0; hseg < (MIDK ? 2 : 1); ++hseg) {
        const int tbeg = MIDK ? hseg * (nt / 2) : 0, tend = MIDK ? tbeg + nt / 2 : nt;
        for (int t = tbeg; t < tend; t += 2) {
            const bool last = (t == nt - 2);
            const char* a1 = cA + (size_t)(t + 1) * kstep;
            const char* a2 = last ? nA : cA + (size_t)(t + 2) * kstep; const char* b2 = last ? nB : cB + (size_t)(t + 2) * kstep;
            const char* a3 = a2 + kstep; const char* b3 = b2 + kstep;
            if (last && has_next) S.a_ready(nxt);
            if constexpr (SP2) {
            PG8_LDB(B0, 0, 0); PG8_LDB(B1, 0, 1); PG8_SCHED; PG8_LDA(At, 0, 0); PG8_STAGE(PG8_SA(1, 1), a1 + hstepA, voffA);
            PG8_WAIT_V(8); PG8_WAIT_L(0); PG8_BAR; PG8_MMA(0, 0, At, B0); PG8_MMA(0, 1, At, B1); PG8_BAR; PG8_SCHED;
            PG8_LDA(At, 0, 1); PG8_STAGE(PG8_SB(0, 0), b2, voffB); PG8_STAGE(PG8_SB(0, 1), b2 + hstepB, voffB); PG8_STAGE(PG8_SA(0, 0), a2, voffA);
            PG8_WAIT_V(8); PG8_WAIT_L(0); PG8_BAR; PG8_MMA(1, 0, At, B0); PG8_MMA(1, 1, At, B1); PG8_BAR; PG8_SCHED;
            PG8_LDB(B0, 1, 0); PG8_LDB(B1, 1, 1); PG8_SCHED; PG8_LDA(At, 1, 0); PG8_STAGE(PG8_SA(0, 1), a2 + hstepA, voffA);
            PG8_WAIT_V(8); PG8_WAIT_L(0); PG8_BAR; PG8_MMA(0, 0, At, B0); PG8_MMA(0, 1, At, B1); PG8_BAR; PG8_SCHED;
            PG8_LDA(At, 1, 1); PG8_STAGE(PG8_SB(1, 0), b3, voffB); PG8_STAGE(PG8_SB(1, 1), b3 + hstepB, voffB); PG8_STAGE(PG8_SA(1, 0), a3, voffA);
            PG8_WAIT_V(8); PG8_WAIT_L(0); PG8_BAR; PG8_MMA(1, 0, At, B0); PG8_MMA(1, 1, At, B1); PG8_BAR; PG8_SCHED;
            } else {
            PG8_LDB(B0, 0, 0); PG8_SCHED; PG8_LDA(At, 0, 0); PG8_STAGE(PG8_SA(1, 1), a1 + hstepA, voffA);
            PG8_WAIT_L(8); PG8_BAR; PG8_WAIT_L(0); PG8_MMA(0, 0, At, B0); PG8_BAR; PG8_SCHED;
            PG8_LDB(B1, 0, 1); PG8_STAGE(PG8_SB(0, 0), b2, voffB);
            PG8_BAR; PG8_WAIT_L(0); PG8_MMA(0, 1, At, B1); PG8_BAR;
            PG8_LDA(At, 0, 1); PG8_STAGE(PG8_SA(0, 0), a2, voffA);
            PG8_BAR; PG8_WAIT_L(0); PG8_MMA(1, 0, At, B0); PG8_BAR; PG8_SCHED;
            PG8_STAGE(PG8_SB(0, 1), b2 + hstepB, voffB);
            PG8_WAIT_V(6); PG8_BAR; PG8_MMA(1, 1, At, B1); PG8_BAR;
            PG8_LDB(B0, 1, 0); PG8_SCHED; PG8_LDA(At, 1, 0); PG8_STAGE(PG8_SA(0, 1), a2 + hstepA, voffA);
            PG8_WAIT_L(8); PG8_BAR; PG8_WAIT_L(0); PG8_MMA(0, 0, At, B0); PG8_BAR; PG8_SCHED;
            PG8_LDB(B1, 1, 1); PG8_STAGE(PG8_SB(1, 0), b3, voffB);
            PG8_BAR; PG8_WAIT_L(0); PG8_MMA(0, 1, At, B1); PG8_BAR;
            PG8_LDA(At, 1, 1); PG8_STAGE(PG8_SA(1, 0), a3, voffA);
            PG8_BAR; PG8_WAIT_L(0); PG8_MMA(1, 0, At, B0); PG8_BAR; PG8_SCHED;
            PG8_STAGE(PG8_SB(1, 1), b3 + hstepB, voffB);
            PG8_WAIT_V(6); PG8_BAR; PG8_MMA(1, 1, At, B1); PG8_BAR;
            }
        }
        if constexpr (MIDK) { if (hseg == 0) E.midk(acc, ui, wr, fr); }
        }
        if constexpr (ALIGN_EPI) { if (wr == 0) PG8_BAR; }
        E(acc, cur, ui, (const PG8_LAS float*)(lds + RV_OFF + (ui & 1) * 1024), wr, wc, fr, fq); S.done(cur);
        if (!has_next) break;
#pragma unroll
        for (int a = 0; a < 2; ++a)
#pragma unroll
            for (int b = 0; b < 2; ++b)
#pragma unroll
                for (int m = 0; m < 4; ++m)
#pragma unroll
                    for (int n = 0; n < 2; ++n) acc[a][b][m][n] = (f32x4){0.f, 0.f, 0.f, 0.f};
        cur = nxt; cA = nA; cB = nB; ++ui;
        if constexpr (ALIGN_EPI) { if (wr == 1) PG8_BAR; }
    }
    PG8_WAIT_V(0);
    if constexpr (!ALIGN_EPI) { if (wr == 0) PG8_BAR; }
    PG8_BAR;
#undef PG8_SA
#undef PG8_SB
#undef PG8_STAGE
#undef PG8_LDA
#undef PG8_LDB
#undef PG8_MMA
#undef PG8_WAIT_V
#undef PG8_WAIT_L
#undef PG8_BAR
#undef PG8_SCHED
}
}

typedef unsigned short bf16;
typedef unsigned v4u __attribute__((ext_vector_type(4)));
typedef unsigned v2u __attribute__((ext_vector_type(2)));
typedef float f32x4 __attribute__((ext_vector_type(4)));
typedef float f32x16 __attribute__((ext_vector_type(16)));
typedef short bf16x8 __attribute__((ext_vector_type(8)));
typedef short s16x4 __attribute__((ext_vector_type(4)));
typedef GAS unsigned gu32;
#define RLX_AGENT __ATOMIC_RELAXED, __HIP_MEMORY_SCOPE_AGENT
#define LDS_WAIT() asm volatile("s_waitcnt lgkmcnt(0)" ::: "memory")
#define VM_WAIT() asm volatile("s_waitcnt vmcnt(0)" ::: "memory")
__device__ __forceinline__ unsigned f2bf(float f) { unsigned u = __builtin_bit_cast(unsigned, f); return (u + 0x7fffu + ((u >> 16) & 1u)) >> 16; }
__device__ __forceinline__ unsigned pk2(float lo, float hi) { return f2bf(lo) | (f2bf(hi) << 16); }
__device__ __forceinline__ float bf2f(unsigned short b) { return __builtin_bit_cast(float, ((unsigned)b) << 16); }

#define XB_TMO      128
#define XB_XCNT(j)  (256  + 64 * (j))
#define XB_XSUB(j)  (1280 + 64 * (j))
#define XB_XGEN(j)  (2304 + 64 * (j))
#define XB_TOP      3328
#define XB_TOPGEN   3392
#define XCD_BAR_WORDS 3456
#define XB_SPIN_CAP (1u << 18)
__device__ __forceinline__ unsigned xb_ld(unsigned* p)              { return __hip_atomic_load(p, __ATOMIC_RELAXED, __HIP_MEMORY_SCOPE_AGENT); }
__device__ __forceinline__ unsigned xb_add(unsigned* p, unsigned v) { return __hip_atomic_fetch_add(p, v, __ATOMIC_RELAXED, __HIP_MEMORY_SCOPE_AGENT); }
__device__ __forceinline__ unsigned xb_xcc_id() { return (unsigned)__builtin_amdgcn_s_getreg((3 << 11) | 20) & 0xFu; }
#define XB_SPIN(cond, bar) do { unsigned _sp = 0; while (cond) { __builtin_amdgcn_s_sleep(1); \
    if ((++_sp & 255u) == 0u) { if (xb_ld(&(bar)[XB_TMO])) break; if (_sp > XB_SPIN_CAP) { atomicAdd(&(bar)[XB_TMO], 1u); break; } } } } while (0)
struct XcdBarrier { unsigned* bar; unsigned x; volatile LAS unsigned* st; };
__device__ __forceinline__ XcdBarrier xcd_barrier_post(unsigned* bar, volatile LAS unsigned* st, const bool leader  ) {
    XcdBarrier b; b.bar = bar; b.x = xb_xcc_id(); b.st = st;
    if (leader) (void)xb_add(&bar[XB_XCNT(b.x)], 1u);
    return b;
}
__device__ __forceinline__ void xcd_barrier_complete(unsigned* bar, unsigned x, unsigned& nloc, unsigned& nx) {
    const unsigned G = gridDim.x * gridDim.y * gridDim.z;
    unsigned sum, cnt, mine, sp = 0u;
    for (;;) {
        sum = 0u; cnt = 0u; mine = 0u;
#pragma unroll
        for (unsigned j = 0; j < 16; ++j) { const unsigned c = xb_ld(&bar[XB_XCNT(j)]); sum += c; cnt += (c > 0u) ? 1u : 0u; mine = (j == x) ? c : mine; }
        if (sum == G) break;
        __builtin_amdgcn_s_sleep(1);
        if ((++sp & 255u) == 0u) { if (xb_ld(&bar[XB_TMO])) break; if (sp > XB_SPIN_CAP) { atomicAdd(&bar[XB_TMO], 1u); break; } }
    }
    nloc = mine > 0u ? mine : 1u; nx = cnt > 0u ? cnt : 1u;
}
__device__ __forceinline__ void xcd_barrier(const XcdBarrier& b, const bool leader  ) {
    asm volatile("s_waitcnt vmcnt(0)" ::: "memory");
    __syncthreads();
    if (leader) {
        unsigned* bar = b.bar;
        __builtin_amdgcn_s_waitcnt(0);
        unsigned nloc = b.st[0], nx = b.st[1];
        if (nloc == 0u) { xcd_barrier_complete(bar, b.x, nloc, nx); b.st[0] = nloc; b.st[1] = nx; }
        const unsigned old = xb_add(&bar[XB_XSUB(b.x)], 1u);
        const unsigned gen = old / nloc;
        if (old + 1u == (gen + 1u) * nloc) {
            __builtin_amdgcn_fence(__ATOMIC_RELEASE, "agent");
            asm volatile("s_waitcnt vmcnt(0)" ::: "memory");
            const unsigned og = xb_add(&bar[XB_TOP], 1u);
            const unsigned tg = og / nx;
            if (og + 1u == (tg + 1u) * nx) xb_add(&bar[XB_TOPGEN], 1u);
            else XB_SPIN(xb_ld(&bar[XB_TOPGEN]) == tg, bar);
            xb_add(&bar[XB_XGEN(b.x)], 1u);
            __builtin_amdgcn_fence(__ATOMIC_ACQUIRE, "agent");
            asm volatile("s_waitcnt vmcnt(0)" ::: "memory");
        } else {
            XB_SPIN(xb_ld(&bar[XB_XGEN(b.x)]) == gen, bar);
            __builtin_amdgcn_fence(__ATOMIC_ACQUIRE, "agent");
            asm volatile("s_waitcnt vmcnt(0)" ::: "memory");
        }
    }
    __syncthreads();
}

constexpr int NWAVES = 8;
struct Args { const float* in[28]; float* out; unsigned char* ws; int ph_lo, ph_hi; };
struct Frame {
    LAS unsigned char* lds;
    volatile LAS unsigned* MISC;
    gu32* ctl;
    int tid, lane, wave, G;
    float* out; unsigned char* ws;
};
__device__ __forceinline__ float wave_sum(float v) {
    v = sum16(v); v = sum_r16(v); v = sum_r32(v);
    return v;
}

__device__ __forceinline__ void p0_transpose_item(const float* W, const float* gk, int K, int N, bf16* WT, int mode, LAS float* scr, int item, int lane) {
    const int nblk = N / 32, kb = item / nblk, nb = item % nblk, k0 = 64 * kb, n0 = 32 * nb;
    { f32x4 v[8]; float g[8];
#pragma unroll
      for (int i = 0; i < 8; ++i) { const int kk = 8 * i + (lane >> 3); v[i] = *(const GAS f32x4*)(W + (size_t)(k0 + kk) * N + n0 + 4 * (lane & 7)); g[i] = gk ? gk[k0 + kk] : 1.0f; }
#pragma unroll
      for (int i = 0; i < 8; ++i) { const int kk = 8 * i + (lane >> 3); LAS float* d = scr + kk * 33 + 4 * (lane & 7); d[0] = v[i].x * g[i]; d[1] = v[i].y * g[i]; d[2] = v[i].z * g[i]; d[3] = v[i].w * g[i]; } }
    LDS_WAIT(); asm volatile("" ::: "memory");
    const int c = lane & 7;
#pragma unroll
    for (int j = 0; j < 4; ++j) { const int n = n0 + (lane >> 3) + 8 * j; const LAS float* s = scr + (8 * c) * 33 + (n - n0);
        v4u o; o.x = pk2(s[0 * 33], s[1 * 33]); o.y = pk2(s[2 * 33], s[3 * 33]); o.z = pk2(s[4 * 33], s[5 * 33]); o.w = pk2(s[6 * 33], s[7 * 33]);
        const int drow = mode == 0 ? n : (256 * (n >> 7) + (n & 127) + (mode == 2 ? 128 : 0));
        *(GAS v4u*)(WT + (size_t)drow * K + k0 + 8 * c) = o; }
    LDS_WAIT(); asm volatile("" ::: "memory");
}
__constant__ int BUCKET_TH[15] = {22, 30, 40, 54, 73, 99, 134, 182, 246, 332, 450, 609, 825, 1117, 1513};
__device__ __forceinline__ float t2_value(const float* rel_bias, int h, int d) {
    const int m = (d <= 128 ? 1 : 0) + (((d & 3) == 0 && d <= 512) ? 1 : 0) + (((d & 15) == 0 && d <= 2048) ? 1 : 0);
    if (m == 0) return -__builtin_inff();
    int bucket = d;
    if (d >= 16) { bucket = 16; for (int k = 0; k < 15; ++k) bucket += (d >= BUCKET_TH[k]) ? 1 : 0; if (bucket > 31) bucket = 31; }
    const float lm = m == 1 ? 0.f : (m == 2 ? 0.6931471805599453f : 1.0986122886681098f);
    return (rel_bias[bucket * NH + h] + lm) * LOG2E;
}
__device__ __forceinline__ void p0_prologue(Frame& F, const Args& AR) {
    LAS float* scr = (LAS float*)(F.lds + F.wave * 16384);
    const int gw = blockIdx.x * NWAVES + F.wave, NGW = F.G * NWAVES;
    unsigned char* ws = F.ws;
    constexpr int I_GU = (DM / 64) * (DFF / 32), I_DN = (DFF / 64) * (DM / 32), I_IN = (DM / 64) * (NIN / 32), I_OUT = (DM / 64) * (DM / 32);
    constexpr int NITEMS = 4 * I_GU + 2 * I_DN + I_IN + I_OUT;
    for (int it = gw; it < NITEMS; it += NGW) {
        int r = it;
        if (r < I_GU) { p0_transpose_item(AR.in[7], AR.in[6], DM, DFF, (bf16*)(ws + WS_WGU1), 1, scr, r, F.lane); continue; } r -= I_GU;
        if (r < I_GU) { p0_transpose_item(AR.in[8], AR.in[6], DM, DFF, (bf16*)(ws + WS_WGU1), 2, scr, r, F.lane); continue; } r -= I_GU;
        if (r < I_DN) { p0_transpose_item(AR.in[9], nullptr, DFF, DM, (bf16*)(ws + WS_WD1), 0, scr, r, F.lane); continue; } r -= I_DN;
        if (r < I_GU) { p0_transpose_item(AR.in[24], AR.in[23], DM, DFF, (bf16*)(ws + WS_WGU2), 1, scr, r, F.lane); continue; } r -= I_GU;
        if (r < I_GU) { p0_transpose_item(AR.in[25], AR.in[23], DM, DFF, (bf16*)(ws + WS_WGU2), 2, scr, r, F.lane); continue; } r -= I_GU;
        if (r < I_DN) { p0_transpose_item(AR.in[26], nullptr, DFF, DM, (bf16*)(ws + WS_WD2), 0, scr, r, F.lane); continue; } r -= I_DN;
        if (r < I_IN) { p0_transpose_item(AR.in[11], AR.in[10], DM, NIN, (bf16*)(ws + WS_WIN), 0, scr, r, F.lane); continue; } r -= I_IN;
        { const int kb = r / (DM / 32); const float* gk = (64 * kb < AW) ? AR.in[20] : (AR.in[21] - AW);
          p0_transpose_item(AR.in[22], gk, DM, DM, (bf16*)(ws + WS_WOUT), 0, scr, r, F.lane); }
    }
    bf16* XA = (bf16*)(ws + WS_XA); float* rs1 = (float*)(ws + WS_RS1);
    for (int m0 = gw; m0 < MP + MS; m0 += 2 * NGW) {
        f32x4 v[2][8]; float s[2] = {0.f, 0.f};
#pragma unroll
        for (int q = 0; q < 2; ++q) { const int m = m0 + q * NGW; if (m < MP + MS) {
            const float* src = m < MP ? AR.in[0] + (size_t)m * DM : AR.in[1] + (size_t)(m - MP) * DM;
            const GAS f32x4* xr = (const GAS f32x4*)src + F.lane;
#pragma unroll
            for (int j = 0; j < 8; ++j) v[q][j] = xr[64 * j]; } }
#pragma unroll
        for (int q = 0; q < 2; ++q) { const int m = m0 + q * NGW; if (m < MP + MS) {
#pragma unroll
            for (int j = 0; j < 8; ++j) s[q] += (v[q][j].x * v[q][j].x + v[q][j].y * v[q][j].y) + (v[q][j].z * v[q][j].z + v[q][j].w * v[q][j].w);
            s[q] = wave_sum(s[q]);
            if (F.lane == 0) rs1[m] = 1.0f / sqrtf(s[q] * (1.0f / DM) + RMS_EPS);
            GAS unsigned long long* o8 = (GAS unsigned long long*)(XA + (size_t)m * DM) + F.lane;
#pragma unroll
            for (int j = 0; j < 8; ++j) o8[64 * j] = (unsigned long long)pk2(v[q][j].x, v[q][j].y) | ((unsigned long long)pk2(v[q][j].z, v[q][j].w) << 32); } }
    }
    const int gt = blockIdx.x * (NWAVES * 64) + F.tid, NGT = F.G * NWAVES * 64;
    float* ssq2 = (float*)(ws + WS_SSQ2); float* ssq3 = (float*)(ws + WS_SSQ3); float* ssq4 = (float*)(ws + WS_SSQ4);
    for (int i = gt; i < MPAD; i += NGT) { ssq2[i] = 0.f; ssq3[i] = 0.f; ssq4[i] = 0.f; }
    float* tbl = (float*)(ws + WS_TBL);
    for (int i = gt; i < NH * TBN; i += NGT) { const int h = i / TBN, j = i % TBN, d = 2048 - j; tbl[i] = d >= 0 ? t2_value(AR.in[19], h, d) : -__builtin_inff(); }
    bf16* wax = (bf16*)(ws + WS_WAX);
    for (int i = gt; i < 8 * 2 * 128 * 128; i += NGT) {
        const int j = i & 7, l = (i >> 3) & 63, kb = (i >> 9) & 3, w = (i >> 11) & 7, g = (i >> 14) & 1, n = i >> 15;
        const int k = 32 * kb + 8 * (l >> 4) + j, c = 16 * w + (l & 15);
        wax[i] = (bf16)f2bf((g ? AR.in[16] : AR.in[14])[((size_t)n * 128 + k) * 128 + c]);
    }
}

namespace at {
constexpr int SHM = 16384;
constexpr int TBW0 = 1504, TBWS = 834;
constexpr int V_OFF = 0, K_OFF = 2 * SHM, WSC_OFF = 4 * SHM, TB_OFF = WSC_OFF + 2048, FT_OFF = TB_OFF + 8 * TBWS * 4, LDS_END = FT_OFF + (132 + 196) * 4;
static_assert(LDS_END <= RING_BYTES, "attention lds");
#define KSWZ(row, colB) ((row) * 256 + ((colB) ^ (((row) & 7) << 4)))
__device__ __forceinline__ int v_st(int k, int c) { const int kk = (k & ~0xC) | ((k & 4) << 1) | ((k & 8) >> 1); return ((kk >> 3) * 4 + (c >> 5)) * 512 + ((kk & 7) * 32 + (c & 31)) * 2; }
__device__ __forceinline__ int v_rd_base(int lane) { return ((lane & 3) << 3) | (((lane >> 2) & 3) << 6) | (((lane >> 4) & 1) << 5) | (((lane >> 5) & 1) << 8); }
constexpr int v_rd_off(int d0, int ks, int half) { return d0 * 512 + ks * 4096 + half * 2048; }
__device__ __forceinline__ int crow(int r, int hi) { return (r & 3) + 8 * (r >> 2) + 4 * hi; }
__device__ __forceinline__ unsigned cvtpk(float lo, float hi) { unsigned r; asm volatile("v_cvt_pk_bf16_f32 %0, %1, %2" : "=v"(r) : "v"(lo), "v"(hi)); return r; }

constexpr float SM_THR = 11.0f;
__device__ __forceinline__ void partialSM(f32x16& p0, f32x16& p1, float& m_reg, float l_reg, float& delta, float& alpha) {
    float pmax = p0[0];
#pragma unroll
    for (int r = 1; r < 16; ++r) pmax = fmaxf(pmax, p0[r]);
#pragma unroll
    for (int r = 0; r < 16; ++r) pmax = fmaxf(pmax, p1[r]);
    { auto rr = __builtin_amdgcn_permlane32_swap(__float_as_uint(pmax), __float_as_uint(pmax), false, false);
      pmax = fmaxf(__uint_as_float(rr[0]), __uint_as_float(rr[1])); }
    const bool need = (pmax > SM_THR) || (l_reg == 0.f && pmax < -SM_THR && pmax > -__builtin_inff());
    if (!__any(need)) { delta = 0.f; alpha = 1.f;
#pragma unroll
        for (int r = 0; r < 16; ++r) p0[r] = __builtin_amdgcn_exp2f(p0[r]);
    } else { delta = need ? pmax : 0.f; alpha = __builtin_amdgcn_exp2f(-delta); m_reg += delta;
#pragma unroll
        for (int r = 0; r < 16; ++r) p0[r] = __builtin_amdgcn_exp2f(p0[r] - delta); }
}
__device__ __forceinline__ void finishSM(f32x16& p0, f32x16& p1, float delta, float alpha, float& l_reg, bf16x8& pa0, bf16x8& pa1, bf16x8& pa2, bf16x8& pa3) {
    if (__all(delta == 0.f)) {
#pragma unroll
        for (int r = 0; r < 16; ++r) p1[r] = __builtin_amdgcn_exp2f(p1[r]);
    } else {
#pragma unroll
        for (int r = 0; r < 16; ++r) p1[r] = __builtin_amdgcn_exp2f(p1[r] - delta); }
    float ps = 0;
#pragma unroll
    for (int r = 0; r < 16; ++r) ps += p0[r];
#pragma unroll
    for (int r = 0; r < 16; ++r) ps += p1[r];
    { auto rr = __builtin_amdgcn_permlane32_swap(__float_as_uint(ps), __float_as_uint(ps), false, false);
      ps = __uint_as_float(rr[0]) + __uint_as_float(rr[1]); }
    l_reg = l_reg * alpha + ps;
#define PK4(P, B_, OUT) do { unsigned a0 = cvtpk(P[B_+0], P[B_+1]), a1 = cvtpk(P[B_+2], P[B_+3]);                          \
        unsigned b0 = cvtpk(P[B_+4], P[B_+5]), b1 = cvtpk(P[B_+6], P[B_+7]);                                             \
        auto r0 = __builtin_amdgcn_permlane32_swap(a0, b0, false, false); auto r1 = __builtin_amdgcn_permlane32_swap(a1, b1, false, false); \
        v4u w = {r0[0], r1[0], r0[1], r1[1]}; OUT = __builtin_bit_cast(bf16x8, w); } while (0)
    PK4(p0, 0, pa0); PK4(p0, 8, pa1); PK4(p1, 0, pa2); PK4(p1, 8, pa3);
#undef PK4
}
template <int KB>
__device__ __forceinline__ void qkt(f32x16& p0, f32x16& p1, const LAS char* K_lds, int r32, int hi, const bf16x8* qr, const LAS float* tb, float mref) {
    unsigned ka[4];
#pragma unroll
    for (int dd = 0; dd < 4; ++dd) ka[dd] = (unsigned)(uintptr_t)(K_lds + KSWZ(r32, (dd * 16 + hi * 8) * 2));
#define KRD(dst, d0_, half_) asm volatile("ds_read_b128 %0, %1 offset:%2" : "=&v"(dst) : "v"(ka[(d0_) & 3]), "i"(KB * SHM + ((d0_) >> 2) * 128 + (half_) * 8192) : "memory")
#define KSTEP(d0_, cur_, nxt_, WAITN) do { if ((d0_) + 2 < 8) { KRD(kl[nxt_], (d0_) + 2, 0); KRD(kh[nxt_], (d0_) + 2, 1); } \
        asm volatile("s_waitcnt lgkmcnt(" #WAITN ")" ::: "memory"); __builtin_amdgcn_sched_barrier(0); \
        p0 = __builtin_amdgcn_mfma_f32_32x32x16_bf16(kl[cur_], qr[d0_], p0, 0, 0, 0); p1 = __builtin_amdgcn_mfma_f32_32x32x16_bf16(kh[cur_], qr[d0_], p1, 0, 0, 0); } while (0)
    bf16x8 kl[3], kh[3];
    KRD(kl[0], 0, 0); KRD(kh[0], 0, 1); KRD(kl[1], 1, 0); KRD(kh[1], 1, 1);
#pragma unroll
    for (int r = 0; r < 16; ++r) { const int c = (r & 3) + 8 * (r >> 2); p0[r] = tb[c] - mref; p1[r] = tb[c + 32] - mref; }
    asm volatile("s_waitcnt lgkmcnt(0)" ::: "memory"); __builtin_amdgcn_sched_barrier(0);
    KSTEP(0, 0, 2, 2); KSTEP(1, 1, 0, 2); KSTEP(2, 2, 1, 4); KSTEP(3, 0, 2, 4); KSTEP(4, 1, 0, 4); KSTEP(5, 2, 1, 4); KSTEP(6, 0, 2, 2); KSTEP(7, 1, 0, 0);
#undef KSTEP
#undef KRD
}
template <int VB>
__device__ __forceinline__ void pv_tile(f32x16* o, unsigned vb0, bf16x8 pa0, bf16x8 pa1, bf16x8 pa2, bf16x8 pa3) {
#define TRRD(dst, off) asm volatile("ds_read_b64_tr_b16 %0, %1 offset:%2" : "=&v"(dst) : "v"(vb0), "i"(off) : "memory")
#define PV_RD(S, d0) do { constexpr int b_ = VB * SHM + v_rd_off(d0, 0, 0); \
        TRRD(S[0], b_); TRRD(S[1], b_ + 2048); TRRD(S[2], b_ + 4096); TRRD(S[3], b_ + 6144); TRRD(S[4], b_ + 8192); TRRD(S[5], b_ + 10240); TRRD(S[6], b_ + 12288); TRRD(S[7], b_ + 14336); } while (0)
#define PV_MM(S, d0) do { \
        o[d0] = __builtin_amdgcn_mfma_f32_32x32x16_bf16(pa0, (bf16x8){S[0][0], S[0][1], S[0][2], S[0][3], S[1][0], S[1][1], S[1][2], S[1][3]}, o[d0], 0, 0, 0);   \
        o[d0] = __builtin_amdgcn_mfma_f32_32x32x16_bf16(pa1, (bf16x8){S[2][0], S[2][1], S[2][2], S[2][3], S[3][0], S[3][1], S[3][2], S[3][3]}, o[d0], 0, 0, 0);   \
        o[d0] = __builtin_amdgcn_mfma_f32_32x32x16_bf16(pa2, (bf16x8){S[4][0], S[4][1], S[4][2], S[4][3], S[5][0], S[5][1], S[5][2], S[5][3]}, o[d0], 0, 0, 0);   \
        o[d0] = __builtin_amdgcn_mfma_f32_32x32x16_bf16(pa3, (bf16x8){S[6][0], S[6][1], S[6][2], S[6][3], S[7][0], S[7][1], S[7][2], S[7][3]}, o[d0], 0, 0, 0); } while (0)
#define PV_WAIT(N) do { asm volatile("s_waitcnt lgkmcnt(" #N ")" ::: "memory"); __builtin_amdgcn_sched_barrier(0); } while (0)
    s16x4 A[8], B[8];
    PV_RD(A, 0);
    PV_RD(B, 1); PV_WAIT(8); PV_MM(A, 0);
    PV_RD(A, 2); PV_WAIT(8); PV_MM(B, 1);
    PV_RD(B, 3); PV_WAIT(8); PV_MM(A, 2);
    PV_WAIT(0); PV_MM(B, 3);
#undef PV_RD
#undef PV_MM
#undef PV_WAIT
#undef TRRD
}
__device__ __forceinline__ void far_softmax(f32x16& p0, float& m_reg, float& l_reg, float& alpha, bf16x8& pa0, bf16x8& pa1) {
    float pmax = p0[0];
#pragma unroll
    for (int r = 1; r < 16; ++r) pmax = fmaxf(pmax, p0[r]);
    { auto rr = __builtin_amdgcn_permlane32_swap(__float_as_uint(pmax), __float_as_uint(pmax), false, false);
      pmax = fmaxf(__uint_as_float(rr[0]), __uint_as_float(rr[1])); }
    const bool need = (pmax > SM_THR) || (l_reg == 0.f && pmax < -SM_THR && pmax > -__builtin_inff());
    float delta = 0.f; alpha = 1.f;
    if (__any(need)) { delta = need ? pmax : 0.f; alpha = __builtin_amdgcn_exp2f(-delta); m_reg += delta; }
    float ps = 0.f;
#pragma unroll
    for (int r = 0; r < 16; ++r) { p0[r] = __builtin_amdgcn_exp2f(p0[r] - delta); ps += p0[r]; }
    { auto rr = __builtin_amdgcn_permlane32_swap(__float_as_uint(ps), __float_as_uint(ps), false, false);
      ps = __uint_as_float(rr[0]) + __uint_as_float(rr[1]); }
    l_reg = l_reg * alpha + ps;
#define PK4(P, B_, OUT) do { unsigned a0 = cvtpk(P[B_+0], P[B_+1]), a1 = cvtpk(P[B_+2], P[B_+3]);                          \
        unsigned b0 = cvtpk(P[B_+4], P[B_+5]), b1 = cvtpk(P[B_+6], P[B_+7]);                                             \
        auto r0 = __builtin_amdgcn_permlane32_swap(a0, b0, false, false); auto r1 = __builtin_amdgcn_permlane32_swap(a1, b1, false, false); \
        v4u w = {r0[0], r1[0], r0[1], r1[1]}; OUT = __builtin_bit_cast(bf16x8, w); } while (0)
    PK4(p0, 0, pa0); PK4(p0, 8, pa1);
#undef PK4
}
}

__device__ __forceinline__ void attn_unit(Frame& F, int b, int h, int qb) {
    using namespace at;
    int tid = F.tid, lane = F.lane; asm volatile("" : "+v"(tid), "+v"(lane));
    const int wid = F.wave, r32 = lane & 31, hi = lane >> 5;
    LAS char* V_lds = (LAS char*)F.lds + V_OFF; LAS char* K_lds = (LAS char*)F.lds + K_OFF;
    LAS float* wsc = (LAS float*)(F.lds + WSC_OFF) + wid * 64; LAS float* li_l = wsc; LAS float* al_l = wsc + 32;
    LAS float* TB = (LAS float*)(F.lds + TB_OFF);
    const int P0 = qb * 256, NT = 4 * (qb + 1), rowbase = b * SP;
    const float* gt = (const float*)(F.ws + WS_TBL) + h * TBN;
    for (int i = tid; i < 8 * TBWS; i += NWAVES * 64) { const int k = i / TBWS, e_ = i - k * TBWS; TB[i] = gt[TBW0 + e_ - 32 * k]; }
    LAS float* FT = (LAS float*)(F.lds + FT_OFF);
    for (int i = tid; i < 129; i += NWAVES * 64) FT[i] = gt[2048 - 16 * i];
    LAS float* FT4 = FT + 132;
    for (int i = tid; i < 196; i += NWAVES * 64) FT4[i] = gt[2048 - 4 * i];
    const int qrow = 16 * (r32 & 15) + 2 * wid + (r32 >> 4), qpos = P0 + qrow;
    const bf16* Qp = (const bf16*)(F.ws + WS_Q) + (size_t)(rowbase + qpos) * AW + h * HD + hi * 8;
    bf16x8 qr[8];
#pragma unroll
    for (int d0 = 0; d0 < 8; ++d0) qr[d0] = *(const bf16x8*)(Qp + d0 * 16);
    float m_reg = 0.f, l_reg = 0.f; f32x16 o[4] = {};
    f32x16 p0, p1; float mn, alpha; bf16x8 pa0, pa1, pa2, pa3;
#define A_RESC() do { if (__any(alpha < 1.f)) { if (hi == 0) al_l[r32] = alpha; LDS_WAIT(); \
            _Pragma("unroll") for (int d_ = 0; d_ < 4; ++d_) _Pragma("unroll") for (int r = 0; r < 16; ++r) o[d_][r] *= al_l[crow(r, hi)]; } } while (0)
    __syncthreads();
    if (qb >= 3) {
        LAS char* fv = (LAS char*)F.lds + wid * 8192;
        const unsigned fvb = (unsigned)(uintptr_t)fv + (unsigned)v_rd_base(lane);
        const int eq = r32 >> 4;
        const bf16* Kf = (const bf16*)(F.ws + WS_KB) + (size_t)(rowbase + 16 * (r32 & 15) + 2 * wid + (r32 >> 4)) * AW + h * HD + hi * 8;
        const bf16* Vf = (const bf16*)(F.ws + WS_VB) + (size_t)(rowbase + 2 * wid) * AW + h * HD;
        const LAS float* tbf = FT + (16 * qb + (r32 & 15) - 4 * hi);
        bf16x8 kf[8], vch[8];
#define FAR_LOADK(f_) do { _Pragma("unroll") for (int d0 = 0; d0 < 8; ++d0) kf[d0] = *(const bf16x8*)(Kf + (size_t)(256 * (f_)) * AW + d0 * 16); } while (0)
#define FAR_LOADV(f_) do { _Pragma("unroll") for (int i = 0; i < 8; ++i) { const int q = lane + 64 * i, rho = q >> 4, chn = q & 15; \
                vch[i] = *(const bf16x8*)(Vf + (size_t)(256 * (f_) + 16 * (rho & 15) + (rho >> 4)) * AW + 8 * chn); } } while (0)
        FAR_LOADK(0); FAR_LOADV(0);
        for (int f = 0; f < qb - 2; ++f) {
#pragma unroll
            for (int r = 0; r < 8; ++r) { const int kk0 = (r & 3) + 8 * ((r >> 2) & 1); const float bias = tbf[-16 * f - kk0] - m_reg;
                p0[r] = (eq == 0) ? bias : -__builtin_inff();
                p0[r + 8] = (eq == 1) ? bias : -__builtin_inff(); }
#pragma unroll
            for (int d0 = 0; d0 < 8; ++d0) p0 = __builtin_amdgcn_mfma_f32_32x32x16_bf16(kf[d0], qr[d0], p0, 0, 0, 0);
            asm volatile("" : "+v"(p0));
            if (f + 1 < qb - 2) FAR_LOADK(f + 1);
#pragma unroll
            for (int i = 0; i < 8; ++i) { const int q = lane + 64 * i, rho = q >> 4, chn = q & 15; *(LAS bf16x8*)(fv + v_st(rho, 8 * chn)) = vch[i]; }
            asm volatile("" ::: "memory");
            if (f + 1 < qb - 2) FAR_LOADV(f + 1);
            far_softmax(p0, m_reg, l_reg, alpha, pa0, pa1);
            A_RESC();
            LDS_WAIT();
#define TRRD(dst, off) asm volatile("ds_read_b64_tr_b16 %0, %1 offset:%2" : "=&v"(dst) : "v"(fvb), "i"(off) : "memory")
#define FPV(d0) do { s16x4 l0, h0, l1, h1; constexpr int b_ = v_rd_off(d0, 0, 0); TRRD(l0, b_); TRRD(h0, b_ + 2048); TRRD(l1, b_ + 4096); TRRD(h1, b_ + 6144); \
                asm volatile("s_waitcnt lgkmcnt(0)" ::: "memory"); __builtin_amdgcn_sched_barrier(0); \
                o[d0] = __builtin_amdgcn_mfma_f32_32x32x16_bf16(pa0, (bf16x8){l0[0], l0[1], l0[2], l0[3], h0[0], h0[1], h0[2], h0[3]}, o[d0], 0, 0, 0); \
                o[d0] = __builtin_amdgcn_mfma_f32_32x32x16_bf16(pa1, (bf16x8){l1[0], l1[1], l1[2], l1[3], h1[0], h1[1], h1[2], h1[3]}, o[d0], 0, 0, 0); } while (0)
            FPV(0); FPV(1); FPV(2); FPV(3);
#undef FPV
#undef TRRD
        }
#undef FAR_LOADK
#undef FAR_LOADV
    }
    __syncthreads();
    const int kb_lo = P0 > 512 ? P0 - 512 : 0;
    const int nmid = P0 >= 128 ? (P0 - 128 - kb_lo) >> 6 : 0;
    const int t_lo = qb >= 1 ? 4 * qb - 2 : 0;
    const int sr = tid >> 4, sc = (tid & 15) * 8, vst0 = v_st(sr, sc), vst1 = v_st(32 + sr, sc), kws = KSWZ(sr, sc * 2), mra = 4 * (sr & 15) + (sr >> 4);
    const bf16* Kp = (const bf16*)(F.ws + WS_KB) + (size_t)rowbase * AW + h * HD + sc;
    const bf16* Vp = (const bf16*)(F.ws + WS_VB) + (size_t)rowbase * AW + h * HD + sc;
    bf16x8 st_k0, st_k1, st_v0, st_v1;
#define A_LOAD(n_) do { const int n__ = (n_); const bool md_ = n__ < nmid; const int kb_ = md_ ? kb_lo + 64 * n__ : 64 * (t_lo + n__ - nmid); \
                         const int ra_ = kb_ + (md_ ? mra : sr), rb_ = kb_ + (md_ ? mra + 2 : sr + 32); \
                         st_k0 = *(const bf16x8*)(Kp + (size_t)ra_ * AW); st_k1 = *(const bf16x8*)(Kp + (size_t)rb_ * AW); \
                         st_v0 = *(const bf16x8*)(Vp + (size_t)ra_ * AW); st_v1 = *(const bf16x8*)(Vp + (size_t)rb_ * AW); } while (0)
#define A_WRITE(bf) do { *(LAS bf16x8*)(K_lds + (bf) * SHM + kws) = st_k0; *(LAS bf16x8*)(K_lds + (bf) * SHM + kws + 32 * 256) = st_k1; \
                         *(LAS bf16x8*)(V_lds + (bf) * SHM + vst0) = st_v0; *(LAS bf16x8*)(V_lds + (bf) * SHM + vst1) = st_v1; } while (0)
    A_LOAD(0); A_WRITE(0);
    __syncthreads();
    const unsigned vb0 = (unsigned)(uintptr_t)V_lds + (unsigned)v_rd_base(lane);
    int n = 0;
    if (nmid > 0) {
        const int eq = r32 >> 4, c0 = (2 * wid) & 3, c1 = (2 * wid + 1) & 3;
        const int rowsel = 16 * (eq ? c1 : c0) + (r32 & 15);
        int kam[4];
#pragma unroll
        for (int dd = 0; dd < 4; ++dd) kam[dd] = KSWZ(rowsel, (dd * 16 + hi * 8) * 2);
        const unsigned vbm0 = vb0 + 4096u * (unsigned)c0, vbm1 = vb0 + 4096u * (unsigned)c1;
        const LAS float* tbm = FT4 + ((P0 - kb_lo) / 4 + 4 * (r32 & 15) + ((2 * wid + eq) >> 2) - 4 * hi);
#define TRRD(dst, base, off) asm volatile("ds_read_b64_tr_b16 %0, %1 offset:%2" : "=&v"(dst) : "v"(base), "i"(off) : "memory")
#define MPV(bf, d0) do { s16x4 l0, h0, l1, h1; constexpr int b_ = (bf) * SHM + v_rd_off(d0, 0, 0); TRRD(l0, vbm0, b_); TRRD(h0, vbm0, b_ + 2048); TRRD(l1, vbm1, b_); TRRD(h1, vbm1, b_ + 2048); \
            asm volatile("s_waitcnt lgkmcnt(0)" ::: "memory"); __builtin_amdgcn_sched_barrier(0); \
            o[d0] = __builtin_amdgcn_mfma_f32_32x32x16_bf16(pa0, (bf16x8){l0[0], l0[1], l0[2], l0[3], h0[0], h0[1], h0[2], h0[3]}, o[d0], 0, 0, 0); \
            o[d0] = __builtin_amdgcn_mfma_f32_32x32x16_bf16(pa1, (bf16x8){l1[0], l1[1], l1[2], l1[3], h1[0], h1[1], h1[2], h1[3]}, o[d0], 0, 0, 0); } while (0)
#define M_STEP(n_, bf) do { \
            A_LOAD((n_) + 1);                                   \
            bf16x8 kf[8]; \
            _Pragma("unroll") for (int d0 = 0; d0 < 8; ++d0) kf[d0] = *(const LAS bf16x8*)(K_lds + (bf) * SHM + kam[d0 & 3] + (d0 >> 2) * 128); \
            _Pragma("unroll") for (int r = 0; r < 8; ++r) { const int kk0 = (r & 3) + 8 * ((r >> 2) & 1); const float bias = tbm[-16 * (n_) - kk0] - m_reg; \
                p0[r] = (eq == 0) ? bias : -__builtin_inff(); p0[r + 8] = (eq == 1) ? bias : -__builtin_inff(); } \
            _Pragma("unroll") for (int d0 = 0; d0 < 8; ++d0) p0 = __builtin_amdgcn_mfma_f32_32x32x16_bf16(kf[d0], qr[d0], p0, 0, 0, 0); \
            far_softmax(p0, m_reg, l_reg, alpha, pa0, pa1); \
            A_RESC(); \
            MPV(bf, 0); MPV(bf, 1); MPV(bf, 2); MPV(bf, 3); \
            A_WRITE((bf) ^ 1); \
            __syncthreads(); } while (0)
        for (; n < nmid; n += 2) { M_STEP(n, 0); M_STEP(n + 1, 1); }
#undef M_STEP
#undef MPV
#undef TRRD
    }
    const LAS float* tbq = TB + ((r32 & 15) >> 1) * TBWS + (2048 - P0 - 2 * wid - (r32 >> 4) + 4 * hi - TBW0 - 16 * (r32 & 1));
#define A_STEP(n_, t, bf) do { \
        if ((t) + 1 < NT) A_LOAD((n_) + 1); \
        qkt<bf>(p0, p1, K_lds, r32, hi, qr, tbq + (t) * 64, m_reg); \
        partialSM(p0, p1, m_reg, l_reg, mn, alpha);        \
        A_RESC(); \
        finishSM(p0, p1, mn, alpha, l_reg, pa0, pa1, pa2, pa3); \
        pv_tile<bf>(o, vb0, pa0, pa1, pa2, pa3); \
        if ((t) + 1 < NT) A_WRITE((bf) ^ 1); \
        __syncthreads(); } while (0)
    for (int t = t_lo; t < NT; t += 2, n += 2) { A_STEP(n, t, 0); A_STEP(n + 1, t + 1, 1); }
#undef A_STEP
#undef A_LOAD
#undef A_WRITE
#undef A_RESC
    if (hi == 0) li_l[r32] = l_reg;
    LDS_WAIT();
    bf16* Ow = (bf16*)(F.ws + WS_GRP) + (size_t)(rowbase + P0 + 2 * wid) * DM + h * HD;
    float* ssqa = (float*)(F.ws + WS_SSQA) + (size_t)(rowbase + P0 + 2 * wid) * 8 + h;
#pragma unroll
    for (int r = 0; r < 16; ++r) {
        const int rr = crow(r, hi), orow = 16 * (rr & 15) + (rr >> 4); const float rl = 1.0f / li_l[rr]; float sq = 0.f;
#pragma unroll
        for (int d0 = 0; d0 < 4; ++d0) { const float v = o[d0][r] * rl; sq += v * v; const float vn = dppf<0xB1>(v);
            if ((r32 & 1) == 0) *(unsigned*)(Ow + (size_t)orow * DM + d0 * 32 + r32) = cvtpk(v, vn); }
        sq = sum16(sq); sq = sum_r16(sq);
        if (r32 == 0) ssqa[(size_t)orow * 8] = sq;
    }
    __syncthreads();
}

__device__ __forceinline__ void sattn_unit(Frame& F, const Args& AR, int b, int h) {
    int lane = F.lane; asm volatile("" : "+v"(lane));
    const int wid = F.wave, t = lane >> 4, seg = lane & 15;
    const int row = MP + TS * b + t;
    const bf16* qp = (const bf16*)(F.ws + WS_Q) + (size_t)row * AW + h * HD + 8 * seg;
    float qf[8];
    { const v4u qv = *(const v4u*)qp; const unsigned qw[4] = {qv.x, qv.y, qv.z, qv.w};
#pragma unroll
      for (int j = 0; j < 4; ++j) { qf[2 * j] = bf2f((unsigned short)(qw[j] & 0xffffu)); qf[2 * j + 1] = bf2f((unsigned short)(qw[j] >> 16)); } }
    const float* ck = AR.in[2]; const float* cv = AR.in[3];
    const float* gt = (const float*)(F.ws + WS_TBL) + h * TBN;
    float m = -1e30f, l = 0.f, acc[8];
#pragma unroll
    for (int j = 0; j < 8; ++j) acc[j] = 0.f;
#define SA_LOAD(K0, K1, V0, V1, TB_, di_raw_, valid_) do { const int di = (di_raw_); \
            const int d = di < 129 ? di : (di < 225 ? 128 + 4 * (di - 128) : 512 + 16 * (di - 224)); \
            const int i = 2048 + t - d; \
            const float* kp; const float* vp; \
            if (i < 2048) { const size_t off = (((size_t)b * 2048 + i) * NH + h) * HD + 8 * seg; kp = ck + off; vp = cv + off; } \
            else { const size_t off = (size_t)(TS * b + (i - 2048)) * AW + h * HD + 8 * seg; kp = F.out + OFF_KS + off; vp = F.out + OFF_VS + off; } \
            K0 = *(const f32x4*)kp; K1 = *(const f32x4*)(kp + 4); V0 = *(const f32x4*)vp; V1 = *(const f32x4*)(vp + 4); \
            TB_ = (valid_) ? gt[2048 - d] : -__builtin_inff(); } while (0)
#define SA_ACC(K0, K1, V0, V1, TB_) do { \
            float dot = ((qf[0] * K0[0] + qf[1] * K0[1]) + (qf[2] * K0[2] + qf[3] * K0[3])) + ((qf[4] * K1[0] + qf[5] * K1[1]) + (qf[6] * K1[2] + qf[7] * K1[3])); \
            dot = sum16(dot); \
            const float s2 = dot + TB_;                                      \
            const float mn = fmaxf(m, s2), al = __builtin_amdgcn_exp2f(m - mn), p = __builtin_amdgcn_exp2f(s2 - mn); \
            l = l * al + p; m = mn; \
            _Pragma("unroll") for (int j = 0; j < 4; ++j) { acc[j] = acc[j] * al + p * V0[j]; acc[4 + j] = acc[4 + j] * al + p * V1[j]; } } while (0)
    f32x4 ke0, ke1, ve0, ve1; float tbe;
    SA_LOAD(ke0, ke1, ve0, ve1, tbe, 320, wid == 0);
    for (int k0 = 0; k0 < 40; k0 += 8) {
        f32x4 k0v[8], k1v[8], v0v[8], v1v[8]; float tb[8];
#pragma unroll
        for (int u = 0; u < 8; ++u) SA_LOAD(k0v[u], k1v[u], v0v[u], v1v[u], tb[u], wid + NWAVES * (k0 + u), true);
#pragma unroll
        for (int u = 0; u < 8; ++u) SA_ACC(k0v[u], k1v[u], v0v[u], v1v[u], tb[u]);
    }
    SA_ACC(ke0, ke1, ve0, ve1, tbe);
#undef SA_LOAD
#undef SA_ACC
    LAS float* sm = (LAS float*)F.lds;
    { LAS float* s = sm + (wid * 64 + lane) * 10; s[0] = m; s[1] = l;
#pragma unroll
      for (int j = 0; j < 8; ++j) s[2 + j] = acc[j]; }
    __syncthreads();
    if (wid == 0) {
        float M = -1e30f;
#pragma unroll
        for (int w = 0; w < NWAVES; ++w) M = fmaxf(M, sm[(w * 64 + lane) * 10]);
        float L = 0.f, O[8];
#pragma unroll
        for (int j = 0; j < 8; ++j) O[j] = 0.f;
#pragma unroll
        for (int w = 0; w < NWAVES; ++w) { const LAS float* s = sm + (w * 64 + lane) * 10; const float e = __builtin_amdgcn_exp2f(s[0] - M); L += s[1] * e;
#pragma unroll
            for (int j = 0; j < 8; ++j) O[j] += s[2 + j] * e; }
        const float rl = 1.0f / L; float sq = 0.f;
#pragma unroll
        for (int j = 0; j < 8; ++j) { O[j] *= rl; sq += O[j] * O[j]; }
        v4u w4; w4.x = pk2(O[0], O[1]); w4.y = pk2(O[2], O[3]); w4.z = pk2(O[4], O[5]); w4.w = pk2(O[6], O[7]);
        *(v4u*)((bf16*)(F.ws + WS_GRP) + (size_t)row * DM + h * HD + 8 * seg) = w4;
        sq = sum16(sq);
        if (seg == 0) ((float*)(F.ws + WS_SSQA))[(size_t)row * 8 + h] = sq;
    }
    __syncthreads();
}

namespace lru {
constexpr int TS_ = 272;
constexpr int UB_OFF = 0, GT_OFF = 2 * 64 * TS_  , YT_OFF = 4 * 64 * TS_  , LDS_END = 6 * 64 * TS_;
static_assert(LDS_END <= RING_BYTES, "lru lds");
}
__device__ __forceinline__ void lru_unit(Frame& F, const Args& AR, int rowbase, int T, int n, const float* prefix, const float* h0, float* conv_out, float* h_out) {
    using namespace lru;
    int tid = F.tid, l = F.lane; asm volatile("" : "+v"(tid), "+v"(l));
    const int w = F.wave, cl = l & 15, tq = l >> 4;
    const int chl = 16 * w + cl, ch = 128 * n + chl;
    const float ba2 = AR.in[15][ch] * -LOG2E, bx2 = AR.in[17][ch] * -LOG2E;
    const float lam = AR.in[18][ch];
    const float LA2 = -8.0f * log1pf(expf(-lam)) * LOG2E;
    float hc = h0 ? h0[ch] : 0.f;
    bf16x8 bfa[4], bfx[4];
    { const bf16* wax = (const bf16*)(F.ws + WS_WAX);
#pragma unroll
      for (int kb = 0; kb < 4; ++kb) { bfa[kb] = *(const bf16x8*)(wax + ((size_t)((((n * 2 + 0) * 8 + w) * 4 + kb) * 64 + l)) * 8);
                                       bfx[kb] = *(const bf16x8*)(wax + ((size_t)((((n * 2 + 1) * 8 + w) * 4 + kb) * 64 + l)) * 8); } }
    const int c4 = tid & 31, tr = tid >> 5;
    const int cg = 128 * n + 4 * c4;
    f32x4 cw[4];
#pragma unroll
    for (int j = 0; j < 4; ++j) cw[j] = *(const f32x4*)(AR.in[12] + j * AW + cg);
    const f32x4 cb = *(const f32x4*)(AR.in[13] + cg);
    const bf16* XL = (const bf16*)(F.ws + WS_XL);
    const bf16* GG = (const bf16*)(F.ws + WS_GG);
    bf16* YL = (bf16*)(F.ws + WS_GRP) + AW;
    float* ssql = (float*)(F.ws + WS_SSQL);
    const int io_row = tid >> 4, io_c8 = (tid & 15) * 8;
    f32x4 x[7]; v4u gch[2];
    const bf16* xlp = XL + ((size_t)rowbase + 4 * tr - 3) * AW + cg;
    const bf16* ggp = GG + ((size_t)rowbase + io_row) * AW + 128 * n + io_c8;
    bf16* ylp = YL + ((size_t)rowbase + io_row) * DM + 128 * n + io_c8;
    float* sqp = ssql + ((size_t)rowbase + io_row) * 8 + n;
#define LRU_X4(w_) ((f32x4){__builtin_bit_cast(float, (w_).x << 16), __builtin_bit_cast(float, (w_).x & 0xffff0000u), __builtin_bit_cast(float, (w_).y << 16), __builtin_bit_cast(float, (w_).y & 0xffff0000u)})
#define LRU_LOADX(sc_) do { if ((sc_) >= 64 && (sc_) + 64 <= T) {              \
            _Pragma("unroll") for (int r = 0; r < 7; ++r) { const v2u w_ = *(const v2u*)(xlp + (size_t)((sc_) + r) * AW); x[r] = LRU_X4(w_); } \
            gch[0] = *(const v4u*)(ggp + (size_t)(sc_) * AW); gch[1] = *(const v4u*)(ggp + (size_t)((sc_) + 32) * AW); \
        } else { \
            _Pragma("unroll") for (int r = 0; r < 7; ++r) { const int tt = (sc_) + 4 * tr - 3 + r; \
                if (tt < 0) x[r] = prefix ? *(const f32x4*)(prefix + (3 + tt) * AW + cg) : (f32x4){0.f, 0.f, 0.f, 0.f}; \
                else if (tt < T) { const v2u w_ = *(const v2u*)(xlp + (size_t)((sc_) + r) * AW); x[r] = LRU_X4(w_); } \
                else x[r] = (f32x4){0.f, 0.f, 0.f, 0.f}; } \
            _Pragma("unroll") for (int k = 0; k < 2; ++k) { const int t_ = (sc_) + io_row + 32 * k; gch[k] = t_ < T ? *(const v4u*)(ggp + (size_t)((sc_) + 32 * k) * AW) : (v4u){0u, 0u, 0u, 0u}; } } } while (0)
#define LRU_CONVW(buf_, sc_) do { LAS unsigned char* UBw = F.lds + UB_OFF + (buf_) * 64 * TS_; LAS unsigned char* GTw = F.lds + GT_OFF + (buf_) * 64 * TS_; \
        _Pragma("unroll") for (int i = 0; i < 4; ++i) { const int tl = 4 * tr + i; \
            const f32x4 u = cb + cw[0] * x[i] + cw[1] * x[i + 1] + cw[2] * x[i + 2] + cw[3] * x[i + 3]; \
            v2u ub; ub.x = pg8::cvt_pk_bf16(u[0], u[1]); ub.y = pg8::cvt_pk_bf16(u[2], u[3]); \
            *(LAS v2u*)(UBw + tl * TS_ + 8 * c4) = ub; } \
        if ((sc_) + 64 >= T) { _Pragma("unroll") for (int i = 0; i < 4; ++i) { const int t = (sc_) + 4 * tr + i; if (t < T && t >= T - 3) *(f32x4*)(conv_out + (t - (T - 3)) * AW + cg) = x[i + 3]; } } \
        _Pragma("unroll") for (int k = 0; k < 2; ++k) *(LAS v4u*)(GTw + (io_row + 32 * k) * TS_ + 2 * io_c8) = gch[k]; } while (0)
#define LRU_FLUSH(buf_, sc_) do { const LAS unsigned char* YTr = F.lds + YT_OFF + (buf_) * 64 * TS_; \
        _Pragma("unroll") for (int k = 0; k < 2; ++k) { const int row_ = io_row + 32 * k, t_ = (sc_) + row_; const v4u yv = *(const LAS v4u*)(YTr + row_ * TS_ + 2 * io_c8); \
            const unsigned yw[4] = {yv.x, yv.y, yv.z, yv.w}; float sq = 0.f; \
            _Pragma("unroll") for (int j = 0; j < 4; ++j) { const float a_ = __builtin_bit_cast(float, yw[j] << 16), b_ = __builtin_bit_cast(float, yw[j] & 0xffff0000u); sq += a_ * a_ + b_ * b_; } \
            sq = sum16(sq); \
            if (t_ < T) { *(v4u*)(ylp + (size_t)((sc_) + 32 * k) * DM) = yv; if ((tid & 15) == 0) sqp[(size_t)((sc_) + 32 * k) * 8] = sq; } } } while (0)
    const int nsc = (T + 63) >> 6;
    float hlast = 0.f;
    LRU_LOADX(0); LRU_CONVW(0, 0);
    __syncthreads();
    for (int s = 0; s < nsc; ++s) {
        const int sc = 64 * s, cur = s & 1;
        const bool more = s + 1 < nsc, lastsc = !more;
        if (more) LRU_LOADX(sc + 64);
        if (s > 0) LRU_FLUSH(cur ^ 1, sc - 64);
        const LAS unsigned char* UB = F.lds + UB_OFF + cur * 64 * TS_; const LAS unsigned char* GT = F.lds + GT_OFF + cur * 64 * TS_;
        LAS unsigned char* YT = F.lds + YT_OFF + cur * 64 * TS_;
        f32x4 accA[4], accX[4];
#pragma unroll
        for (int rt = 0; rt < 4; ++rt) { accA[rt] = (f32x4){0.f, 0.f, 0.f, 0.f}; accX[rt] = (f32x4){0.f, 0.f, 0.f, 0.f};
#pragma unroll
            for (int kb = 0; kb < 4; ++kb) { const bf16x8 a = *(const LAS bf16x8*)(UB + (16 * rt + cl) * TS_ + (32 * kb + 8 * tq) * 2);
                accA[rt] = __builtin_amdgcn_mfma_f32_16x16x32_bf16(a, bfa[kb], accA[rt], 0, 0, 0);
                accX[rt] = __builtin_amdgcn_mfma_f32_16x16x32_bf16(a, bfx[kb], accX[rt], 0, 0, 0); } }
#pragma unroll
        for (int rt = 0; rt < 4; ++rt) {
            float av[4], bv[4], gv[4];
#pragma unroll
            for (int i = 0; i < 4; ++i) { const int tl = 16 * rt + 4 * tq + i;
                const float ra = pg8::fast_rcp(1.0f + pg8::fast_exp2(fmaf(accA[rt][i], -LOG2E, ba2))), ix = pg8::fast_rcp(1.0f + pg8::fast_exp2(fmaf(accX[rt][i], -LOG2E, bx2)));
                const float a = __builtin_amdgcn_exp2f(ra * LA2);
                const float mult = __builtin_amdgcn_sqrtf(fmaxf(fmaf(-a, a, 1.0f), 0.f));
                const float uf = bf2f(*(const LAS unsigned short*)(UB + tl * TS_ + 2 * chl));
                gv[i] = bf2f(*(const LAS unsigned short*)(GT + tl * TS_ + 2 * chl));
                av[i] = a; bv[i] = mult * ix * uf; }
            float A = av[0], B = bv[0];
#pragma unroll
            for (int i = 1; i < 4; ++i) { B = B * av[i] + bv[i]; A = A * av[i]; }
            float Ag[4], Bg[4];
#pragma unroll
            for (int j = 0; j < 4; ++j) { Ag[j] = __builtin_bit_cast(float, __builtin_amdgcn_ds_bpermute((cl + 16 * j) << 2, __builtin_bit_cast(int, A))); Bg[j] = __builtin_bit_cast(float, __builtin_amdgcn_ds_bpermute((cl + 16 * j) << 2, __builtin_bit_cast(int, B))); }
            float hin = hc, hend = hc;
#pragma unroll
            for (int j = 0; j < 4; ++j) { if (j < tq) hin = Ag[j] * hin + Bg[j]; hend = Ag[j] * hend + Bg[j]; }
            float hh = hin, yv_[4];
#pragma unroll
            for (int i = 0; i < 4; ++i) { const int t = sc + 16 * rt + 4 * tq + i;
                hh = av[i] * hh + bv[i];
                if (lastsc) hlast = (t == T - 1) ? hh : hlast;
                yv_[i] = hh * gv[i]; }
            { const unsigned p01 = pg8::cvt_pk_bf16(yv_[0], yv_[1]), p23 = pg8::cvt_pk_bf16(yv_[2], yv_[3]);
              LAS unsigned char* yp = YT + (16 * rt + 4 * tq) * TS_ + 2 * chl;
              *(LAS unsigned short*)(yp) = (unsigned short)(p01 & 0xffffu); *(LAS unsigned short*)(yp + TS_) = (unsigned short)(p01 >> 16);
              *(LAS unsigned short*)(yp + 2 * TS_) = (unsigned short)(p23 & 0xffffu); *(LAS unsigned short*)(yp + 3 * TS_) = (unsigned short)(p23 >> 16); }
            hc = hend;
        }
        if (more) LRU_CONVW(cur ^ 1, sc + 64);
        __syncthreads();
    }
    LRU_FLUSH((nsc - 1) & 1, 64 * (nsc - 1));
    { const int tl_last = (T - 1) - 64 * (nsc - 1); if ((tl_last >> 2 & 3) == tq) h_out[ch] = hlast; }
    __syncthreads();
#undef LRU_LOADX
#undef LRU_CONVW
#undef LRU_FLUSH
#undef LRU_X4
}

enum { SK_SWIGLU = 0, SK_RES = 1, SK_IN = 2, SK_OUT = 3 };
struct SkP {
    const bf16* A; int lda; const bf16* B; int ldb; int K; int ncg;
    const float* rs; const float* ssq_in;
    bf16* Hout;
    const float* base; bf16* xa; float* ssq_out; float coef;
    bf16* Q; bf16* Kb; bf16* Vb; bf16* GG; bf16* XL; float* out;
};
template <int KIND>
__device__ __forceinline__ void skinny_phase(Frame& F, const SkP& P, const float* sca = nullptr, const float* scl = nullptr) {
    int l = F.lane, tid = F.tid; asm volatile("" : "+v"(l), "+v"(tid));
    const int w = F.wave, lr = l & 15, lq = l >> 4;
    constexpr int NB = KIND == SK_SWIGLU ? 2 : 1;
    constexpr int CGN = (KIND == SK_SWIGLU || KIND == SK_IN) ? 3 : 1;
    constexpr int BSTEP = CGN == 3 ? 1 : 2, DEPTH = 3;
    constexpr int NBF = CGN * NB;
    LAS float* red = (LAS float*)F.lds;
    const int half_g = F.G >> 1, kw = P.K / 8, nbat = kw / (32 * BSTEP);
    const int rh = blockIdx.x & 1, cg0 = blockIdx.x >> 1;
    if (cg0 < P.ncg) {
        bool cgv[CGN]; const bf16* Bb[NBF];
#pragma unroll
        for (int j = 0; j < CGN; ++j) { const int cg = cg0 + j * half_g; cgv[j] = cg < P.ncg; const int c0 = 16 * (cgv[j] ? cg : cg0);
            int brow = c0 + lr; if (KIND == SK_SWIGLU) brow = 256 * (c0 >> 7) + (c0 & 127) + lr;
            Bb[j * NB] = P.B + (size_t)brow * P.ldb + w * kw + 8 * lq; if (NB == 2) Bb[j * NB + NB - 1] = Bb[j * NB] + (size_t)128 * P.ldb; }
        const bf16* Ab = P.A + (size_t)(64 * rh + lr) * P.lda + w * kw + 8 * lq;
        const size_t rstep = (size_t)16 * P.lda;
        pg8::f32x4 acc[4][NBF];
#pragma unroll
        for (int rt = 0; rt < 4; ++rt)
#pragma unroll
            for (int q = 0; q < NBF; ++q) acc[rt][q] = (pg8::f32x4){0.f, 0.f, 0.f, 0.f};
        bf16x8 ra[DEPTH][BSTEP][4], rb[DEPTH][BSTEP][NBF];
#define SK_LOAD(d_, b_) do { _Pragma("unroll") for (int u = 0; u < BSTEP; ++u) { const int k_ = ((b_) * BSTEP + u) * 32; \
            _Pragma("unroll") for (int rt = 0; rt < 4; ++rt) ra[d_][u][rt] = *(const bf16x8*)(Ab + rt * rstep + k_); \
            _Pragma("unroll") for (int q = 0; q < NBF; ++q) rb[d_][u][q] = *(const bf16x8*)(Bb[q] + k_); } } while (0)
#define SK_MMA(d_) do { _Pragma("unroll") for (int u = 0; u < BSTEP; ++u) _Pragma("unroll") for (int rt = 0; rt < 4; ++rt) _Pragma("unroll") for (int q = 0; q < NBF; ++q) \
            acc[rt][q] = __builtin_amdgcn_mfma_f32_16x16x32_bf16(rb[d_][u][q], ra[d_][u][rt], acc[rt][q], 0, 0, 0); } while (0)
        SK_LOAD(0, 0); if (1 < nbat) SK_LOAD(1, 1); if (2 < nbat) SK_LOAD(2, 2);
        for (int b = 0; b < nbat; b += 3) {
            SK_MMA(0); if (b + 3 < nbat) SK_LOAD(0, b + 3);
            if (b + 1 < nbat) { SK_MMA(1); if (b + 4 < nbat) SK_LOAD(1, b + 4); }
            if (b + 2 < nbat) { SK_MMA(2); if (b + 5 < nbat) SK_LOAD(2, b + 5); }
        }
#undef SK_LOAD
#undef SK_MMA
        if (KIND == SK_OUT) {
#pragma unroll
            for (int rt = 0; rt < 4; ++rt) { const int R = MP + 64 * rh + 16 * rt + lr; const float* sp = (w >= 4 ? scl : sca) + (size_t)R * 8;
                const pg8::f32x4 x = *(const pg8::f32x4*)sp, y = *(const pg8::f32x4*)(sp + 4);
                const float t = ((x[0] + x[1]) + (x[2] + x[3])) + ((y[0] + y[1]) + (y[2] + y[3])); acc[rt][0] = acc[rt][0] * (1.0f / sqrtf(t * (1.0f / AW) + RMS_EPS)); } }
#pragma unroll
        for (int j = 0; j < CGN; ++j) {
            if (!cgv[j]) continue;
            const int c0 = 16 * (cg0 + j * half_g);
#pragma unroll
            for (int rt = 0; rt < 4; ++rt)
#pragma unroll
                for (int nb = 0; nb < NB; ++nb) *(LAS pg8::f32x4*)(red + ((((nb * 8 + w) * 64) + 16 * rt + lr) * 4 + lq) * 4) = acc[rt][j * NB + nb];
            __syncthreads();
            if (tid < 256) {
                const int row = tid >> 2, qd = tid & 3, m = 64 * rh + row, R = MP + m, c = c0 + 4 * qd;
                pg8::f32x4 acc0 = {0.f, 0.f, 0.f, 0.f}, acc1 = {0.f, 0.f, 0.f, 0.f};
#pragma unroll
                for (int ww = 0; ww < 8; ++ww) { acc0 = acc0 + *(const LAS pg8::f32x4*)(red + (((ww * 64) + row) * 4 + qd) * 4); if (NB == 2) acc1 = acc1 + *(const LAS pg8::f32x4*)(red + ((((8 + ww) * 64) + row) * 4 + qd) * 4); }
                if (KIND == SK_SWIGLU) {
                    const float s = P.ssq_in ? 1.0f / sqrtf(P.ssq_in[R] * (1.0f / DM) + RMS_EPS) : P.rs[R];
                    float h[4];
#pragma unroll
                    for (int jj = 0; jj < 4; ++jj) h[jj] = pg8::silu_f(acc0[jj] * s) * (acc1[jj] * s);
                    v2u o; o.x = pg8::cvt_pk_bf16(h[0], h[1]); o.y = pg8::cvt_pk_bf16(h[2], h[3]);
                    *(v2u*)(P.Hout + (size_t)R * HLD + c) = o;
                } else if (KIND == SK_RES || KIND == SK_OUT) {
                    pg8::f32x4 b;
                    if (P.base) b = *(const pg8::f32x4*)(P.base + (size_t)m * DM + c);
                    else { const v2u wv = *(const v2u*)(P.xa + (size_t)R * DM + c);
                        b = (pg8::f32x4){__builtin_bit_cast(float, wv.x << 16), __builtin_bit_cast(float, wv.x & 0xffff0000u), __builtin_bit_cast(float, wv.y << 16), __builtin_bit_cast(float, wv.y & 0xffff0000u)}; }
                    const pg8::f32x4 x = b + acc0 * P.coef;
                    { v2u o; o.x = pg8::cvt_pk_bf16(x[0], x[1]); o.y = pg8::cvt_pk_bf16(x[2], x[3]); *(v2u*)(P.xa + (size_t)R * DM + c) = o;
                      float ss = (x[0] * x[0] + x[1] * x[1]) + (x[2] * x[2] + x[3] * x[3]); ss = sum_x1(ss); ss = sum_x2(ss);
                      if (qd == 0) __hip_atomic_fetch_add(P.ssq_out + R, ss, __ATOMIC_RELAXED, __HIP_MEMORY_SCOPE_AGENT); }
                } else {
                    const float s = 1.0f / sqrtf(P.ssq_in[R] * (1.0f / DM) + RMS_EPS);
                    pg8::f32x4 v = acc0 * s; const int seg = c0 >> 10, cs = (c0 & 1023) + 4 * qd;
                    v2u o; o.x = pg8::cvt_pk_bf16(v[0], v[1]); o.y = pg8::cvt_pk_bf16(v[2], v[3]);
                    if (seg == 0) { v2u oq; oq.x = pg8::cvt_pk_bf16(v[0] * ATT_C2, v[1] * ATT_C2); oq.y = pg8::cvt_pk_bf16(v[2] * ATT_C2, v[3] * ATT_C2); *(v2u*)(P.Q + (size_t)R * AW + cs) = oq; }
                    else if (seg == 1) { *(v2u*)(P.Kb + (size_t)R * AW + cs) = o; *(pg8::f32x4*)(P.out + OFF_KS + (size_t)m * AW + cs) = v; }
                    else if (seg == 2) { *(v2u*)(P.Vb + (size_t)R * AW + cs) = o; *(pg8::f32x4*)(P.out + OFF_VS + (size_t)m * AW + cs) = v; }
                    else if (seg == 3) *(v2u*)(P.XL + (size_t)R * AW + cs) = o;
                    else {
#pragma unroll
                        for (int jj = 0; jj < 4; ++jj) v[jj] = pg8::gelu_tanh_f(v[jj]);
                        o.x = pg8::cvt_pk_bf16(v[0], v[1]); o.y = pg8::cvt_pk_bf16(v[2], v[3]); *(v2u*)(P.GG + (size_t)R * AW + cs) = o; }
                }
            }
            __syncthreads();
        }
    }
}

constexpr int N_LAUNCHES = MK_N_LAUNCHES, N_PHASES = 9;
__global__ void __launch_bounds__(NWAVES * 64, 2) mega_fwd(Args args) {
    extern __shared__ __attribute__((aligned(16))) unsigned char lds[];
    Frame F;
    F.lds = (LAS unsigned char*)lds;
    F.MISC = (volatile LAS unsigned*)(F.lds + MISC_OFF);
    const int wave0 = __builtin_amdgcn_readfirstlane((int)threadIdx.x >> 6);
    F.wave = wave0; F.lane = (int)__builtin_amdgcn_mbcnt_hi(~0u, __builtin_amdgcn_mbcnt_lo(~0u, 0u)); F.tid = wave0 * 64 + F.lane;
    F.G = gridDim.x;
    unsigned char* ws = args.ws; F.ws = ws; F.out = args.out;
    F.ctl = (gu32*)(ws + WS_CTL);
    for (int u = F.tid; u < (LDS_BYTES - LDSCTL_OFF) / 4; u += NWAVES * 64) ((LAS unsigned*)(F.lds + LDSCTL_OFF))[u] = 0u;
    __syncthreads();
    XcdBarrier bar; bar.bar = (unsigned*)(F.ctl + CW_BAR); bar.x = 0; bar.st = nullptr;
    if (N_LAUNCHES == 1) bar = xcd_barrier_post((unsigned*)(F.ctl + CW_BAR), F.MISC + 8, F.tid == 0);
#define GRID_BAR() do { if (N_LAUNCHES == 1) { REFRESH_F(); xcd_barrier(bar, F.tid == 0); } } while (0)
    const int lo = args.ph_lo, hi = args.ph_hi;
#define REFRESH_F() do { unsigned z_ = 0u; asm volatile("" : "+v"(z_));   const int l_ = (int)__builtin_amdgcn_mbcnt_hi(~0u, __builtin_amdgcn_mbcnt_lo(~0u, z_)); F.lane = l_; F.wave = wave0; F.tid = wave0 * 64 + l_; } while (0)
#define IN(k) (lo <= (k) && (k) < hi)
#define BOTH(k) (IN(k) && IN((k) + 1))
    float* out = args.out;
    pg8::bf16_t* XA = (pg8::bf16_t*)(ws + WS_XA); pg8::bf16_t* Hb = (pg8::bf16_t*)(ws + WS_H); pg8::bf16_t* GRP = (pg8::bf16_t*)(ws + WS_GRP);

    if (IN(0)) { REFRESH_F(); p0_prologue(F, args); if (BOTH(0)) GRID_BAR(); }

    if (IN(1)) {
        REFRESH_F();
        pg8::Gemm g{XA, (const pg8::bf16_t*)(ws + WS_WGU1), MP, NGU, DM, DM, DM}; pg8::StaticOrder S; S.init(MP, NGU, F.G, (int)blockIdx.x);
        pg8::EpiSwiGLU<false> E{Hb, (const float*)(ws + WS_RS1)};
        pg8::gemm_phase<pg8::EpiSwiGLU<false>, pg8::StaticOrder, true, true>(F.lds, g, S, E, F.tid, F.wave);
        { SkP P{}; P.A = XA + (size_t)MP * DM; P.lda = DM; P.B = (const bf16*)(ws + WS_WGU1); P.ldb = DM; P.K = DM; P.ncg = DFF / 16; P.rs = (const float*)(ws + WS_RS1); P.Hout = Hb;
          skinny_phase<SK_SWIGLU>(F, P); }
        if (BOTH(1)) GRID_BAR();
    }
    if (IN(2)) {
        REFRESH_F();
        pg8::Gemm g{Hb, (const pg8::bf16_t*)(ws + WS_WD1), MP, DM, DFF, HLD, DFF}; pg8::StaticOrder S; S.init(MP, DM, F.G, (int)blockIdx.x, true, 4);
        pg8::EpiRes<0, false> E{nullptr, XA, (float*)(ws + WS_SSQ2), nullptr, 0.5f, nullptr};
        pg8::gemm_phase<pg8::EpiRes<0, false>, pg8::StaticOrder, true, true>(F.lds, g, S, E, F.tid, F.wave);
        { SkP P{}; P.A = Hb + (size_t)MP * HLD; P.lda = HLD; P.B = (const bf16*)(ws + WS_WD1); P.ldb = DFF; P.K = DFF; P.ncg = DM / 16;
          P.base = nullptr; P.xa = XA; P.ssq_out = (float*)(ws + WS_SSQ2); P.coef = 0.5f;
          skinny_phase<SK_RES>(F, P); }
        if (BOTH(2)) GRID_BAR();
    }
    if (IN(3)) {
        REFRESH_F();
        pg8::Gemm g{XA, (const pg8::bf16_t*)(ws + WS_WIN), MP, NIN, DM, DM, DM}; pg8::StaticOrder S; S.init(MP, NIN, F.G, (int)blockIdx.x);
        pg8::EpiIn E{(const float*)(ws + WS_SSQ2), (pg8::bf16_t*)(ws + WS_Q), (pg8::bf16_t*)(ws + WS_KB), (pg8::bf16_t*)(ws + WS_VB), (pg8::bf16_t*)(ws + WS_XL), (pg8::bf16_t*)(ws + WS_GG), out};
        pg8::gemm_phase<pg8::EpiIn, pg8::StaticOrder, true, true>(F.lds, g, S, E, F.tid, F.wave);
        { SkP P{}; P.A = XA + (size_t)MP * DM; P.lda = DM; P.B = (const bf16*)(ws + WS_WIN); P.ldb = DM; P.K = DM; P.ncg = NIN / 16; P.ssq_in = (const float*)(ws + WS_SSQ2);
          P.Q = (bf16*)(ws + WS_Q); P.Kb = (bf16*)(ws + WS_KB); P.Vb = (bf16*)(ws + WS_VB); P.GG = (bf16*)(ws + WS_GG); P.XL = (bf16*)(ws + WS_XL); P.out = out;
          skinny_phase<SK_IN>(F, P); }
        if (BOTH(3)) GRID_BAR();
    }
    if (IN(4)) {
        REFRESH_F();
        const int c = (int)blockIdx.x;
        const int nr = F.G - 128;
        for (int k = 0;; ++k) {
            int rowbase, T, n; const float* prefix; const float* h0; float* co; float* ho;
            if (c < 128) { if (k > 0) break; const int b = c >> 3; n = c & 7; rowbase = b * SP; T = SP; prefix = nullptr; h0 = nullptr; co = out + OFF_CP + (size_t)b * 3 * AW; ho = out + OFF_HP + (size_t)b * AW; }
            else { const int u = c - 128 + k * nr; if (u >= BS * 8) break; const int b = u >> 3; n = u & 7; rowbase = MP + TS * b; T = TS; prefix = args.in[4] + (size_t)b * 3 * AW; h0 = args.in[5] + (size_t)b * AW;
                   co = out + OFF_CS + (size_t)b * 3 * AW; ho = out + OFF_HS + (size_t)b * AW; }
            lru_unit(F, args, rowbase, T, n, prefix, h0, co, ho);
        }
        if (c >= 128) for (int u = c - 128; u < BS * NH; u += nr) sattn_unit(F, args, u >> 3, u & 7);
        { if (F.tid == 0) F.MISC[0] = __hip_atomic_fetch_add((unsigned*)(F.ctl + CW_QUEUE), 1u, RLX_AGENT);
          __syncthreads();
          unsigned u = F.MISC[0];
          __syncthreads();
          while (u < (unsigned)(BP * NH * 8)) {
            unsigned nxt = 0u;
            if (F.tid == 0) nxt = __hip_atomic_fetch_add((unsigned*)(F.ctl + CW_QUEUE), 1u, RLX_AGENT);
            const int qb = 7 - (int)(u >> 7), bh = (int)(u & 127);
            attn_unit(F, bh >> 3, bh & 7, qb);
            if (F.tid == 0) F.MISC[0] = nxt;
            __syncthreads();
            u = F.MISC[0];
            __syncthreads();
          } }
        if (BOTH(4)) GRID_BAR();
    }
    if (IN(5)) {
        REFRESH_F();
        pg8::StaticOrder S; S.init(MP, DM, F.G, (int)blockIdx.x, false, 4);
        LAS float* sct = (LAS float*)(F.lds + SCT_OFF);
        { pg8::Unit uu; for (int i = 0; i < 4 && S.next(i, uu); ++i) if (F.tid < 256) { const int row = uu.pm * 256 + F.tid;
              const f32x4 a0 = *(const f32x4*)((const float*)(ws + WS_SSQA) + (size_t)row * 8), a1 = *(const f32x4*)((const float*)(ws + WS_SSQA) + (size_t)row * 8 + 4);
              const f32x4 l0 = *(const f32x4*)((const float*)(ws + WS_SSQL) + (size_t)row * 8), l1 = *(const f32x4*)((const float*)(ws + WS_SSQL) + (size_t)row * 8 + 4);
              const float ta = ((a0[0] + a0[1]) + (a0[2] + a0[3])) + ((a1[0] + a1[1]) + (a1[2] + a1[3])), tl = ((l0[0] + l0[1]) + (l0[2] + l0[3])) + ((l1[0] + l1[1]) + (l1[2] + l1[3]));
              const float sa = 1.0f / sqrtf(ta * (1.0f / AW) + RMS_EPS), sl = 1.0f / sqrtf(tl * (1.0f / AW) + RMS_EPS); sct[(i * 256 + F.tid) * 2 + 0] = sa / sl; sct[(i * 256 + F.tid) * 2 + 1] = sl; }
          __syncthreads(); }
        { pg8::Gemm g{GRP, (const pg8::bf16_t*)(ws + WS_WOUT), MP, DM, DM, DM, DM};
          pg8::EpiRes<2, false> E{nullptr, XA, (float*)(ws + WS_SSQ3), sct, 1.0f, nullptr};
          pg8::gemm_phase<pg8::EpiRes<2, false>, pg8::StaticOrder, true, true, true>(F.lds, g, S, E, F.tid, F.wave); }
        { SkP P{}; P.A = GRP + (size_t)MP * DM; P.lda = DM; P.B = (const bf16*)(ws + WS_WOUT); P.ldb = DM; P.K = DM; P.ncg = DM / 16;
          P.base = nullptr; P.xa = XA; P.ssq_out = (float*)(ws + WS_SSQ3); P.coef = 1.0f;
          skinny_phase<SK_OUT>(F, P, (const float*)(ws + WS_SSQA), (const float*)(ws + WS_SSQL)); }
        if (BOTH(5)) GRID_BAR();
    }
    if (IN(6)) {
        REFRESH_F();
        pg8::Gemm g{XA, (const pg8::bf16_t*)(ws + WS_WGU2), MP, NGU, DM, DM, DM}; pg8::StaticOrder S; S.init(MP, NGU, F.G, (int)blockIdx.x);
        pg8::EpiSwiGLU<true> E{Hb, (const float*)(ws + WS_SSQ3)};
        pg8::gemm_phase<pg8::EpiSwiGLU<true>, pg8::StaticOrder, true, true>(F.lds, g, S, E, F.tid, F.wave);
        { SkP P{}; P.A = XA + (size_t)MP * DM; P.lda = DM; P.B = (const bf16*)(ws + WS_WGU2); P.ldb = DM; P.K = DM; P.ncg = DFF / 16; P.ssq_in = (const float*)(ws + WS_SSQ3); P.Hout = Hb;
          skinny_phase<SK_SWIGLU>(F, P); }
        if (BOTH(6)) GRID_BAR();
    }
    if (IN(7)) {
        REFRESH_F();
        pg8::Gemm g{Hb, (const pg8::bf16_t*)(ws + WS_WD2), MP, DM, DFF, HLD, DFF}; pg8::StaticOrder S; S.init(MP, DM, F.G, (int)blockIdx.x, true, 4);
        pg8::EpiRes<0, false> E{nullptr, XA, (float*)(ws + WS_SSQ4), nullptr, 0.5f, nullptr};
        pg8::gemm_phase<pg8::EpiRes<0, false>, pg8::StaticOrder, true, true>(F.lds, g, S, E, F.tid, F.wave);
        { SkP P{}; P.A = Hb + (size_t)MP * HLD; P.lda = HLD; P.B = (const bf16*)(ws + WS_WD2); P.ldb = DFF; P.K = DFF; P.ncg = DM / 16;
          P.base = nullptr; P.xa = XA; P.ssq_out = (float*)(ws + WS_SSQ4); P.coef = 0.5f;
          skinny_phase<SK_RES>(F, P); }
        if (BOTH(7)) GRID_BAR();
    }
    if (IN(8)) {
        REFRESH_F();
        const int gw = blockIdx.x * NWAVES + F.wave, NGW = F.G * NWAVES;
        f32x4 gfv[8];
        { const GAS f32x4* gf = (const GAS f32x4*)args.in[27] + 2 * F.lane;
#pragma unroll
          for (int j = 0; j < 4; ++j) { gfv[2 * j] = gf[128 * j]; gfv[2 * j + 1] = gf[128 * j + 1]; } }
        const float* ssq4 = (const float*)(ws + WS_SSQ4);
        for (int m0 = gw; m0 < MP + MS; m0 += 2 * NGW) {
            v4u v[2][4]; float rsv[2];
#pragma unroll
            for (int q = 0; q < 2; ++q) { const int m = m0 + q * NGW; if (m < MP + MS) {
                const GAS v4u* xr = (const GAS v4u*)(XA + (size_t)m * DM) + F.lane;
#pragma unroll
                for (int j = 0; j < 4; ++j) v[q][j] = xr[64 * j];
                rsv[q] = ssq4[m]; } }
#pragma unroll
            for (int q = 0; q < 2; ++q) { const int m = m0 + q * NGW; if (m < MP + MS) {
                float* rowp = m < MP ? out + OFF_YP + (size_t)m * DM : out + OFF_YS + (size_t)(m - MP) * DM;
                GAS f32x4* xw = (GAS f32x4*)rowp + 2 * F.lane;
                const float rs = 1.0f / sqrtf(rsv[q] * (1.0f / DM) + RMS_EPS);
#pragma unroll
                for (int j = 0; j < 4; ++j) { const v4u w = v[q][j];
                    const f32x4 a = {__builtin_bit_cast(float, w.x << 16), __builtin_bit_cast(float, w.x & 0xffff0000u), __builtin_bit_cast(float, w.y << 16), __builtin_bit_cast(float, w.y & 0xffff0000u)};
                    const f32x4 b = {__builtin_bit_cast(float, w.z << 16), __builtin_bit_cast(float, w.z & 0xffff0000u), __builtin_bit_cast(float, w.w << 16), __builtin_bit_cast(float, w.w & 0xffff0000u)};
                    xw[128 * j] = a * rs * gfv[2 * j]; xw[128 * j + 1] = b * rs * gfv[2 * j + 1]; } } }
        }
    }
#undef IN
#undef BOTH
#undef GRID_BAR
}

extern "C" void kernel_launch(void* const* d_in, const int* in_sizes, int n_in, void* d_out, int out_size, void* d_ws, size_t ws_size, hipStream_t stream) {
    static int grid = 0;
    if (grid == 0) {
        if (n_in != 28 || in_sizes[0] != MP * DM || (size_t)out_size != OUT_TOTAL || ws_size < WS_END) {
            fprintf(stderr, "kernel_launch: unexpected shapes (n_in %d, in0 %d, out %d, ws %zu); nothing launched\n", n_in, n_in > 0 ? in_sizes[0] : -1, out_size, ws_size); grid = -1; return; }
        int dev = 0, cus = 0, per_cu = 0;
        if (hipGetDevice(&dev) != hipSuccess || hipDeviceGetAttribute(&cus, hipDeviceAttributeMultiprocessorCount, dev) != hipSuccess) { grid = -1; return; }
        if (hipFuncSetAttribute((const void*)mega_fwd, hipFuncAttributeMaxDynamicSharedMemorySize, LDS_BYTES) != hipSuccess) { fprintf(stderr, "kernel_launch: hipFuncSetAttribute failed\n"); grid = -1; return; }
        if (hipOccupancyMaxActiveBlocksPerMultiprocessor(&per_cu, (const void*)mega_fwd, NWAVES * 64, LDS_BYTES) != hipSuccess || per_cu < 1)
            fprintf(stderr, "kernel_launch: occupancy query reports %d workgroups per CU\n", per_cu);
        (void)hipGetLastError();
        grid = cus;
        if (grid < 129) { fprintf(stderr, "kernel_launch: needs >= 129 CUs\n"); grid = -1; return; }
    }
    if (grid < 0) return;
    (void)hipMemsetAsync((char*)d_ws + WS_CTL, 0, CTL_ZERO_BYTES, stream);
    Args a{};
    for (int i = 0; i < 28; ++i) a.in[i] = (const float*)d_in[i];
    a.out = (float*)d_out; a.ws = (unsigned char*)d_ws;
    if (N_LAUNCHES == 1) { a.ph_lo = 0; a.ph_hi = N_PHASES; hipLaunchKernelGGL(mega_fwd, dim3(grid), dim3(NWAVES * 64), LDS_BYTES, stream, a); }
    else for (int li = 0; li < N_PHASES; ++li) { a.ph_lo = li; a.ph_hi = li + 1; hipLaunchKernelGGL(mega_fwd, dim3(grid), dim3(NWAVES * 64), LDS_BYTES, stream, a); }
}
```
